# Optimizing an MI355X kernel written in HIP

```python
import jax, jax.numpy as jnp
from jax import lax
import numpy as np

D_MODEL = 1024
BATCH = 16
SEQ = 2048
DEPTH = 4
DEC_BATCH = 2
DEC_SEQ = 16384
PAST_LEN = 128

GLA_HEADS = 4
GLA_WIDTH = D_MODEL // 2
GLA_DV = GLA_WIDTH // GLA_HEADS
GLA_DK = GLA_DV // 2
GLA_KWIDTH = GLA_HEADS * GLA_DK
GLA_GATE_RANK = 16
GLA_GATE_TAU = 16.0
GLA_CHUNK = 64
SGU_HEADS = 4
SGU_WIDTH = D_MODEL // 4
SGU_HEAD_DIM = SGU_WIDTH // SGU_HEADS
SGU_CHUNK = 128
POOL_WINDOWS = (2, 4, 8, 16)
POOL_GROUPS = len(POOL_WINDOWS)
POOL_WIDTH = D_MODEL // 4
POOL_GROUP_DIM = POOL_WIDTH // POOL_GROUPS
MIX_WIDTH = GLA_WIDTH + SGU_WIDTH + POOL_WIDTH
D_FF = ((8 * D_MODEL // 3 + 127) // 128) * 128
EPS = 1e-6
IN_PARTS = (GLA_KWIDTH, GLA_KWIDTH, GLA_WIDTH, GLA_WIDTH, 2 * GLA_GATE_RANK,
            SGU_WIDTH, SGU_WIDTH, POOL_WIDTH)
IN_WIDTH = sum(IN_PARTS)
IN_SPLITS = tuple(int(s) for s in np.cumsum(IN_PARTS)[:-1])

kernel_name = "hybrid_gla_sgu_pool_encoder"


def rmsnorm(x, g):
    xf = x.astype(jnp.float32)
    y = xf * lax.rsqrt(jnp.mean(xf * xf, axis=-1, keepdims=True) + EPS)
    return (y * g).astype(x.dtype)


def layernorm(x, g, b):
    xf = x.astype(jnp.float32)
    mu = jnp.mean(xf, axis=-1, keepdims=True)
    xc = xf - mu
    y = xc * lax.rsqrt(jnp.mean(xc * xc, axis=-1, keepdims=True) + EPS)
    return (y * g + b).astype(x.dtype)


def gla_direction(q, k, v, log_a):
    B, S, H, DK = q.shape
    DV = v.shape[-1]
    C = GLA_CHUNK
    N = S // C

    def to_chunks(t):
        return t.reshape(B, N, C, H, t.shape[-1]).transpose(0, 3, 1, 2, 4)

    q, k, v, log_a = to_chunks(q), to_chunks(k), to_chunks(v), to_chunks(log_a)
    G = jnp.cumsum(log_a, axis=3)
    G_last = G[:, :, :, -1:, :]
    q_dec = q * jnp.exp(G)
    k_dec = k * jnp.exp(-G)
    mask = jnp.tril(jnp.ones((C, C), dtype=bool))
    A = jnp.where(mask, jnp.einsum('bhnid,bhnjd->bhnij', q_dec, k_dec), 0.0)
    o = jnp.einsum('bhnij,bhnjv->bhniv', A, v)
    kv = jnp.einsum('bhnjd,bhnjv->bhndv', k * jnp.exp(G_last - G), v)
    chunk_decay = jnp.exp(G_last[:, :, :, 0, :])

    def step(state, inp):
        dec, kv_n = inp
        return dec[..., None] * state + kv_n, state

    init = jnp.zeros((B, H, DK, DV), jnp.float32)
    _, prev = lax.scan(step, init, (jnp.moveaxis(chunk_decay, 2, 0), jnp.moveaxis(kv, 2, 0)))
    prev = jnp.moveaxis(prev, 0, 2)
    o = o + jnp.einsum('bhnid,bhndv->bhniv', q_dec, prev)
    return o.transpose(0, 2, 3, 1, 4).reshape(B, S, H, DV)


def gla_mixer(q, k, v, g, lr, w2, b2, norm_g):
    B, S, _ = q.shape
    dt = q.dtype
    qf = q.astype(jnp.float32).reshape(B, S, GLA_HEADS, GLA_DK) * (GLA_DK ** -0.5)
    kf = k.astype(jnp.float32).reshape(B, S, GLA_HEADS, GLA_DK)
    vf = v.astype(jnp.float32).reshape(B, S, GLA_HEADS, GLA_DV)
    lr = lr.astype(jnp.float32).reshape(B, S, 2, GLA_GATE_RANK)
    z = jnp.einsum('bsdr,drk->bsdk', lr, w2.astype(jnp.float32)) + b2.astype(jnp.float32)
    log_a = (jax.nn.log_sigmoid(z) / GLA_GATE_TAU).reshape(B, S, 2, GLA_HEADS, GLA_DK)
    o_f = gla_direction(qf, kf, vf, log_a[:, :, 0])
    flip = lambda t: jnp.flip(t, axis=1)
    o_b = flip(gla_direction(flip(qf), flip(kf), flip(vf), flip(log_a[:, :, 1])))
    o = o_f + o_b
    o = o * lax.rsqrt(jnp.mean(o * o, axis=-1, keepdims=True) + EPS)
    o = o.reshape(B, S, GLA_WIDTH) * norm_g * jax.nn.silu(g.astype(jnp.float32))
    return o.astype(dt)


def spatial_gating(u, v, ln_g, ln_b, w_s, b_s):
    B, S, _ = u.shape
    N = S // SGU_CHUNK
    v = layernorm(v, ln_g, ln_b)
    vh = v.reshape(B, N, SGU_CHUNK, SGU_HEADS, SGU_HEAD_DIM)
    mixed = jnp.einsum('hts,bnshc->bnthc', w_s, vh) + jnp.transpose(b_s)[None, None, :, :, None]
    return (u * mixed.reshape(B, S, SGU_WIDTH)).astype(u.dtype)


def pool_mixer(xp, pool_w, pool_scale):
    B, S, _ = xp.shape
    xf = xp.astype(jnp.float32).reshape(B, S, POOL_GROUPS, POOL_GROUP_DIM)
    cs = jnp.concatenate([jnp.zeros((B, 1, POOL_GROUPS, POOL_GROUP_DIM), jnp.float32),
                          jnp.cumsum(xf, axis=1)], axis=1)
    t = jnp.arange(S)
    pooled = []
    for gi, w in enumerate(POOL_WINDOWS):
        h = w // 2
        lo = jnp.clip(t - h, 0, S)
        hi = jnp.clip(t + h, 0, S)
        cnt = (hi - lo).astype(jnp.float32)[None, :, None]
        c = cs[:, :, gi]
        pooled.append((jnp.take(c, hi, axis=1) - jnp.take(c, lo, axis=1)) / cnt)
    pooled = jnp.stack(pooled, axis=2)
    d = pooled - xf
    y = jnp.einsum('bsgc,gcd->bsgd', d, pool_w.astype(jnp.float32)).reshape(B, S, POOL_WIDTH)
    return (y * pool_scale).astype(xp.dtype)


def conv_glu_ffn(h, w1, conv_w, conv_b, w2):
    a, up = jnp.split(h @ w1, 2, axis=-1)
    ap = jnp.pad(a, ((0, 0), (1, 1), (0, 0)))
    a = ap[:, :-2] * conv_w[0] + ap[:, 1:-1] * conv_w[1] + ap[:, 2:] * conv_w[2] + conv_b
    return (jax.nn.silu(a) * up) @ w2


def trunk(x, norm1_g, w_in, gla_gate_w2, gla_gate_b, gla_norm_g, sgu_ln_g, sgu_ln_b,
          sgu_w, sgu_b, pool_w, pool_scale, w_o, norm2_g, w_ffn_in, conv_w, conv_b,
          w_ffn_out, norm_f):
    for l in range(DEPTH):
        h = rmsnorm(x, norm1_g[l])
        p = h @ w_in[l]
        q, k, v, g, lr, u, vs, xp = jnp.split(p, IN_SPLITS, axis=-1)
        a_out = gla_mixer(q, k, v, g, lr, gla_gate_w2[l], gla_gate_b[l], gla_norm_g[l])
        b_out = spatial_gating(jax.nn.gelu(u), jax.nn.gelu(vs), sgu_ln_g[l], sgu_ln_b[l],
                               sgu_w[l], sgu_b[l])
        c_out = pool_mixer(xp, pool_w[l], pool_scale[l])
        x = x + jnp.concatenate([a_out, b_out, c_out], axis=-1) @ w_o[l]
        h = rmsnorm(x, norm2_g[l])
        x = x + conv_glu_ffn(h, w_ffn_in[l], conv_w[l], conv_b[l], w_ffn_out[l])
    return rmsnorm(x, norm_f)


def setup_inputs(seed: int = 0) -> dict:
    key = jax.random.key(seed)
    ks = jax.random.split(key, 24)
    f32 = jnp.float32
    nrm = lambda k, shape, s: jax.random.normal(k, shape, f32) * s
    return {
        "x_prompt": jax.random.normal(ks[0], (BATCH, SEQ, D_MODEL), f32),
        "x_sample": jax.random.normal(ks[1], (DEC_BATCH, DEC_SEQ, D_MODEL), f32),
        "norm1_g": 1.0 + nrm(ks[2], (DEPTH, D_MODEL), 0.02),
        "w_in": nrm(ks[3], (DEPTH, D_MODEL, IN_WIDTH), D_MODEL ** -0.5),
        "gla_gate_w2": nrm(ks[4], (DEPTH, 2, GLA_GATE_RANK, GLA_KWIDTH), GLA_GATE_RANK ** -0.5),
        "gla_gate_b": nrm(ks[5], (DEPTH, 2, GLA_KWIDTH), 0.1),
        "gla_norm_g": 1.0 + nrm(ks[6], (DEPTH, GLA_WIDTH), 0.02),
        "sgu_ln_g": 1.0 + nrm(ks[7], (DEPTH, SGU_WIDTH), 0.02),
        "sgu_ln_b": nrm(ks[8], (DEPTH, SGU_WIDTH), 0.02),
        "sgu_w": nrm(ks[9], (DEPTH, SGU_HEADS, SGU_CHUNK, SGU_CHUNK), SGU_CHUNK ** -0.5),
        "sgu_b": 1.0 + nrm(ks[10], (DEPTH, SGU_HEADS, SGU_CHUNK), 0.02),
        "pool_w": nrm(ks[11], (DEPTH, POOL_GROUPS, POOL_GROUP_DIM, POOL_GROUP_DIM), POOL_GROUP_DIM ** -0.5),
        "pool_scale": 1.0 + nrm(ks[12], (DEPTH, POOL_WIDTH), 0.1),
        "w_o": nrm(ks[13], (DEPTH, MIX_WIDTH, D_MODEL), MIX_WIDTH ** -0.5),
        "norm2_g": 1.0 + nrm(ks[14], (DEPTH, D_MODEL), 0.02),
        "w_ffn_in": nrm(ks[15], (DEPTH, D_MODEL, 2 * D_FF), D_MODEL ** -0.5),
        "conv_w": nrm(ks[16], (DEPTH, 3, D_FF), 3 ** -0.5),
        "conv_b": nrm(ks[17], (DEPTH, D_FF), 0.02),
        "w_ffn_out": nrm(ks[18], (DEPTH, D_FF, D_MODEL), D_FF ** -0.5),
        "norm_f": 1.0 + nrm(ks[19], (D_MODEL,), 0.02),
    }


def reference(x_prompt, x_sample, norm1_g, w_in, gla_gate_w2, gla_gate_b, gla_norm_g,
              sgu_ln_g, sgu_ln_b, sgu_w, sgu_b, pool_w, pool_scale, w_o, norm2_g,
              w_ffn_in, conv_w, conv_b, w_ffn_out, norm_f):
    y_prompt = trunk(x_prompt, norm1_g, w_in, gla_gate_w2, gla_gate_b, gla_norm_g,
                     sgu_ln_g, sgu_ln_b, sgu_w, sgu_b, pool_w, pool_scale, w_o, norm2_g,
                     w_ffn_in, conv_w, conv_b, w_ffn_out, norm_f)
    y_sample = trunk(x_sample, norm1_g, w_in, gla_gate_w2, gla_gate_b, gla_norm_g,
                     sgu_ln_g, sgu_ln_b, sgu_w, sgu_b, pool_w, pool_scale, w_o, norm2_g,
                     w_ffn_in, conv_w, conv_b, w_ffn_out, norm_f)
    return (y_prompt, y_sample)
```

```cpp
#include <hip/hip_runtime.h>
#include <hip/hip_cooperative_groups.h>
#include <cstdio>
namespace cg = cooperative_groups;
namespace pg8 {
#define PG8_LAS __attribute__((address_space(3)))
typedef unsigned short bf16_t;
typedef short bf16x8 __attribute__((ext_vector_type(8)));
typedef float f32x4 __attribute__((ext_vector_type(4)));
typedef unsigned u32x4 __attribute__((ext_vector_type(4)));
constexpr int BM = 256, BK = 64, HALF = 128, HTB = HALF * BK * 2  , STAGE_BYTES = 8 * HTB, NXCD = 8, WGM = 8;

__host__ __device__ __forceinline__ int lds_byte(int r, int c) { const int st = (r >> 4) * 2 + (c >> 5), rr = r & 15, cc = c & 31, ob = rr * 64 + cc * 2; return st * 1024 + (ob ^ (((ob >> 9) & 1) << 5)); }
__host__ __device__ __forceinline__ void stage_rc(int b, int& R, int& C) { const int st = b / 1024, sb = b % 1024, swz = sb ^ (((sb >> 9) & 1) << 5); R = (st >> 1) * 16 + swz / 64; C = (st & 1) * 32 + (swz % 64) / 2; }
__host__ __device__ __forceinline__ int perm32(int rho) { const int n = rho >> 4, i = rho & 15; return 8 * (i >> 2) + 4 * n + (i & 3); }

struct Unit { int pm, pn; };
struct Gemm { const bf16_t* A; const bf16_t* Bt; int M, N, K; };

struct StaticOrder {
    int nM, nN, nwg, G, c;
    __host__ __device__ void init(int M, int N, int G_, int c_) { nM = M / BM; nN = N / BM; nwg = nM * nN; G = G_; c = c_; }
    __host__ __device__ bool next(int i, Unit& u) const {
        const long L = (long)i * G + c; if (L >= nwg) return false;
        int wgid = (int)L; { const int q = nwg / NXCD, r = nwg % NXCD, xcd = wgid % NXCD, off = wgid / NXCD; wgid = (xcd < r ? xcd * (q + 1) : r * (q + 1) + (xcd - r) * q) + off; }
        const int nig = WGM * nN, gid = wgid / nig, fm = gid * WGM, gsz = (nM - fm) < WGM ? (nM - fm) : WGM;
        u.pm = fm + ((wgid % nig) % gsz); u.pn = (wgid % nig) / gsz; return true;
    }
    __device__ __forceinline__ void a_ready(const Unit&) const {}
    __device__ __forceinline__ void done(const Unit&) const {}
};
typedef __bf16 bf16x2_hw __attribute__((ext_vector_type(2)));
typedef float f32x2_hw __attribute__((ext_vector_type(2)));
__device__ __forceinline__ unsigned cvt_pk_bf16(float lo, float hi) { const f32x2_hw v = {lo, hi}; const bf16x2_hw r = __builtin_convertvector(v, bf16x2_hw); return __builtin_bit_cast(unsigned, r); }
template <class Epi, class Sched, bool STAMP = false>
__device__ __forceinline__ void gemm_phase(PG8_LAS unsigned char* lds, const Gemm g, const Sched& S, const Epi& E, unsigned long long* stamps) {
    int tid_l = threadIdx.x; asm volatile("" : "+v"(tid_l));
    const int tid = tid_l, wid = __builtin_amdgcn_readfirstlane(tid >> 6), lane = tid & 63, wr = wid >> 2, wc = wid & 3, fr = lane & 15, fq = lane >> 4;
    const int K = g.K, nt = K / BK;
    int ts_lo = 0, ts_hi = 0, nts = 0; const unsigned long long rt_entry = STAMP ? (unsigned long long)wall_clock64() : 0ull;
#define PG8_STAMP() do { if (STAMP && wid == 0 && nts < 64) { const unsigned long long _c = (unsigned long long)clock64(); \
        ts_lo = (lane == nts) ? (int)(unsigned)_c : ts_lo; ts_hi = (lane == nts) ? (int)(unsigned)(_c >> 32) : ts_hi; ++nts; } } while (0)
    PG8_STAMP();
    unsigned voffA[2], voffB[2];
#pragma unroll
    for (int i = 0; i < 2; ++i) { int R, C; stage_rc(tid * 16 + i * 8192, R, C); const int Rb = Epi::PERM ? ((R & ~31) + perm32(R & 31)) : R;
        voffA[i] = (unsigned)(R * K + C) * 2u; voffB[i] = (unsigned)(Rb * K + C) * 2u; }
    const size_t kstep = (size_t)(BK * 2);
    const size_t hstep = (size_t)HALF * K * 2;
    const size_t tstep = 2 * hstep;
    const unsigned ldsw = (unsigned)wid * 1024u;
    const int aoff = lds_byte(wr * 64 + fr, fq * 8), boff = lds_byte(wc * 32 + fr, fq * 8);
#define PG8_SA(b, h) (((b) * 2 + (h)) * HTB)
#define PG8_SB(b, h) ((4 + (b) * 2 + (h)) * HTB)
#define PG8_STAGE(bufoff, gbase, voff) do { _Pragma("unroll") for (int _i = 0; _i < 2; ++_i) \
        __builtin_amdgcn_global_load_lds((const unsigned*)((const char*)(gbase) + (voff)[_i]), (PG8_LAS unsigned*)(lds + (bufoff) + ldsw + _i * 8192), 16, 0, 0); } while (0)
#define PG8_LDA(dst, b, h) do { _Pragma("unroll") for (int m = 0; m < 4; ++m) _Pragma("unroll") for (int k = 0; k < 2; ++k) dst[m][k] = *(const PG8_LAS bf16x8*)(lds + PG8_SA(b, h) + aoff + m * 2048 + k * 1024); } while (0)
#define PG8_LDB(dst, b, h) do { _Pragma("unroll") for (int n = 0; n < 2; ++n) _Pragma("unroll") for (int k = 0; k < 2; ++k) dst[n][k] = *(const PG8_LAS bf16x8*)(lds + PG8_SB(b, h) + boff + n * 2048 + k * 1024); } while (0)
#define PG8_MMA(ai, bj, At, Bt) do { __builtin_amdgcn_s_setprio(1); _Pragma("unroll") for (int m = 0; m < 4; ++m) _Pragma("unroll") for (int n = 0; n < 2; ++n) _Pragma("unroll") for (int k = 0; k < 2; ++k) \
        acc[ai][bj][m][n] = __builtin_amdgcn_mfma_f32_16x16x32_bf16(Bt[n][k], At[m][k], acc[ai][bj][m][n], 0, 0, 0); __builtin_amdgcn_s_setprio(0); } while (0)
#define PG8_WAIT_V(n) asm volatile("s_waitcnt vmcnt(" #n ")" ::: "memory")
#define PG8_WAIT_L(n) asm volatile("s_waitcnt lgkmcnt(" #n ")" ::: "memory")
#define PG8_BAR __builtin_amdgcn_s_barrier()
#define PG8_SCHED __builtin_amdgcn_sched_barrier(0)
    Unit cur, nxt; int ui = 0;
    if (!S.next(0, cur)) return;
    f32x4 acc[2][2][4][2];
#pragma unroll
    for (int a = 0; a < 2; ++a)
#pragma unroll
        for (int b = 0; b < 2; ++b)
#pragma unroll
            for (int m = 0; m < 4; ++m)
#pragma unroll
                for (int n = 0; n < 2; ++n) acc[a][b][m][n] = (f32x4){0.f, 0.f, 0.f, 0.f};
    bf16x8 At[4][2], B0[2][2], B1[2][2];
    const char* cA = (const char*)g.A + (size_t)cur.pm * tstep; const char* cB = (const char*)g.Bt + (size_t)cur.pn * tstep;
    S.a_ready(cur);
    PG8_STAGE(PG8_SB(0, 0), cB, voffB); PG8_STAGE(PG8_SA(0, 0), cA, voffA); PG8_STAGE(PG8_SB(0, 1), cB + hstep, voffB); PG8_STAGE(PG8_SA(0, 1), cA + hstep, voffA);
    if (wr == 1) PG8_BAR;
    PG8_WAIT_V(4); PG8_BAR;
    PG8_STAGE(PG8_SB(1, 0), cB + kstep, voffB); PG8_STAGE(PG8_SA(1, 0), cA + kstep, voffA); PG8_STAGE(PG8_SB(1, 1), cB + hstep + kstep, voffB);
    PG8_WAIT_V(6); PG8_BAR;
    PG8_STAMP();
    for (;;) {
        const bool has_next = S.next(ui + 1, nxt);
        const char* nA = has_next ? (const char*)g.A + (size_t)nxt.pm * tstep : cA; const char* nB = has_next ? (const char*)g.Bt + (size_t)nxt.pn * tstep : cB;
        for (int t = 0; t < nt; t += 2) {
            const bool last = (t == nt - 2);
            const char* a1 = cA + (size_t)(t + 1) * kstep;
            const char* a2 = last ? nA : cA + (size_t)(t + 2) * kstep; const char* b2 = last ? nB : cB + (size_t)(t + 2) * kstep;
            const char* a3 = a2 + kstep; const char* b3 = b2 + kstep;
            if (last && has_next) S.a_ready(nxt);
            PG8_LDB(B0, 0, 0); PG8_SCHED; PG8_LDA(At, 0, 0); PG8_STAGE(PG8_SA(1, 1), a1 + hstep, voffA);
            PG8_WAIT_L(8); PG8_BAR; PG8_WAIT_L(0); PG8_MMA(0, 0, At, B0); PG8_BAR; PG8_SCHED;
            PG8_LDB(B1, 0, 1); PG8_STAGE(PG8_SB(0, 0), b2, voffB);
            PG8_BAR; PG8_WAIT_L(0); PG8_MMA(0, 1, At, B1); PG8_BAR;
            PG8_LDA(At, 0, 1); PG8_STAGE(PG8_SA(0, 0), a2, voffA);
            PG8_BAR; PG8_WAIT_L(0); PG8_MMA(1, 0, At, B0); PG8_BAR; PG8_SCHED;
            PG8_STAGE(PG8_SB(0, 1), b2 + hstep, voffB);
            PG8_WAIT_V(6); PG8_BAR; PG8_MMA(1, 1, At, B1); PG8_BAR;
            PG8_LDB(B0, 1, 0); PG8_SCHED; PG8_LDA(At, 1, 0); PG8_STAGE(PG8_SA(0, 1), a2 + hstep, voffA);
            PG8_WAIT_L(8); PG8_BAR; PG8_WAIT_L(0); PG8_MMA(0, 0, At, B0); PG8_BAR; PG8_SCHED;
            PG8_LDB(B1, 1, 1); PG8_STAGE(PG8_SB(1, 0), b3, voffB);
            PG8_BAR; PG8_WAIT_L(0); PG8_MMA(0, 1, At, B1); PG8_BAR;
            PG8_LDA(At, 1, 1); PG8_STAGE(PG8_SA(1, 0), a3, voffA);
            PG8_BAR; PG8_WAIT_L(0); PG8_MMA(1, 0, At, B0); PG8_BAR; PG8_SCHED;
            PG8_STAGE(PG8_SB(1, 1), b3 + hstep, voffB);
            PG8_WAIT_V(6); PG8_BAR; PG8_MMA(1, 1, At, B1); PG8_BAR;
        }
        PG8_STAMP();
        if constexpr (!Epi::AFTER_DRAIN) { E(acc, cur, wr, wc, fr, fq); S.done(cur); }
        PG8_STAMP();
        if (!has_next) break;
#pragma unroll
        for (int a = 0; a < 2; ++a)
#pragma unroll
            for (int b = 0; b < 2; ++b)
#pragma unroll
                for (int m = 0; m < 4; ++m)
#pragma unroll
                    for (int n = 0; n < 2; ++n) acc[a][b][m][n] = (f32x4){0.f, 0.f, 0.f, 0.f};
        cur = nxt; cA = nA; cB = nB; ++ui;
    }
    PG8_WAIT_V(0);
    if (wr == 0) PG8_BAR;
    PG8_BAR;
    if constexpr (Epi::AFTER_DRAIN) { E.fused(acc, cur, wr, wc, fr, fq, lds, wid, lane); S.done(cur); }
    PG8_STAMP();
    if (STAMP && wid == 0) { stamps[lane] = lane < nts ? (((unsigned long long)(unsigned)ts_hi << 32) | (unsigned)ts_lo) : 0ull;
        if (lane == 62) stamps[62] = rt_entry; if (lane == 63) stamps[63] = (unsigned long long)wall_clock64(); }
#undef PG8_STAMP
#undef PG8_SA
#undef PG8_SB
#undef PG8_STAGE
#undef PG8_LDA
#undef PG8_LDB
#undef PG8_MMA
#undef PG8_WAIT_V
#undef PG8_WAIT_L
#undef PG8_BAR
#undef PG8_SCHED
}
}
using namespace pg8;
typedef unsigned u32x2 __attribute__((ext_vector_type(2)));
typedef float f32x2v __attribute__((ext_vector_type(2)));
#define LAS PG8_LAS

constexpr int T_TOK = 65536, DM = 1024, NIN = 2816, DFF = 2816, NLAYER = 4, INW = 2336;
constexpr int PC_Q = 0, PC_K = 256, PC_V = 512, PC_G = 1024, PC_U = 1536, PC_VS = 1792, PC_XP = 2048, PC_ZF = 2304, PC_ZB = 2560;
constexpr float EPSF = 1e-6f;
constexpr size_t WB_IN = 0, WB_O = (size_t)NIN * DM, WB_1 = WB_O + (size_t)DM * DM, WB_2 = WB_1 + (size_t)2 * DFF * DM, WB_LAYER = WB_2 + (size_t)DM * DFF;
constexpr size_t OFF_WB = 0;
constexpr size_t OFF_R1 = OFF_WB + WB_LAYER * 2 * NLAYER;
constexpr size_t OFF_R2 = OFF_R1 + (size_t)T_TOK * NIN * 2;
constexpr size_t OFF_R3 = OFF_R2 + (size_t)T_TOK * DM * 2;
constexpr size_t OFF_SS1 = OFF_R3 + (size_t)T_TOK * DM * 2;
constexpr size_t OFF_SS2 = OFF_SS1 + (size_t)T_TOK * 16 * 4;
constexpr size_t OFF_DEC = OFF_SS2 + (size_t)T_TOK * 16 * 4;
constexpr size_t OFF_END = OFF_DEC + (size_t)8192 * 64 * 4;

struct Params {
    const float* x_prompt; const float* x_sample; const float* norm1_g; const float* w_in; const float* gate_w2; const float* gate_b; const float* gla_norm_g;
    const float* sgu_ln_g; const float* sgu_ln_b; const float* sgu_w; const float* sgu_b; const float* pool_w; const float* pool_scale; const float* w_o; const float* norm2_g;
    const float* w_ffn_in; const float* conv_w; const float* conv_b; const float* w_ffn_out; const float* norm_f;
    float* out; unsigned char* ws;
};

__device__ __forceinline__ unsigned short f2bf(float f) { unsigned u = __float_as_uint(f); u += 0x7FFFu + ((u >> 16) & 1u); return (unsigned short)(u >> 16); }
__device__ __forceinline__ float bf2f(unsigned short b) { return __uint_as_float(((unsigned)b) << 16); }
__device__ __forceinline__ float bflo(unsigned w) { return __uint_as_float(w << 16); }
__device__ __forceinline__ float bfhi(unsigned w) { return __uint_as_float(w & 0xffff0000u); }
__device__ __forceinline__ float sigmoidf_(float x) { return 1.0f / (1.0f + __expf(-x)); }
__device__ __forceinline__ float siluf_(float x) { return x / (1.0f + __expf(-x)); }
__device__ __forceinline__ float gelu_tanh(float x) { const float y = 0.7978845608f * (x + 0.044715f * x * x * x); return x / (1.0f + __expf(-2.0f * y)); }
__device__ __forceinline__ float logsigmoidf_(float z) { return fminf(z, 0.f) - __logf(1.0f + __expf(-fabsf(z))); }
__device__ __forceinline__ float sum16(const float* p) { const f32x4 a = *(const f32x4*)p, b = *(const f32x4*)(p + 4), c = *(const f32x4*)(p + 8), d = *(const f32x4*)(p + 12);
    return ((a[0] + a[1]) + (a[2] + a[3])) + ((b[0] + b[1]) + (b[2] + b[3])) + ((c[0] + c[1]) + (c[2] + c[3])) + ((d[0] + d[1]) + (d[2] + d[3])); }

struct EpiIn {
    static constexpr bool PERM = true, AFTER_DRAIN = false;
    bf16_t* P; const float* ss; const float* gbias;
    __device__ __forceinline__ void operator()(const f32x4 (&acc)[2][2][4][2], const Unit& u, int wr, int wc, int fr, int fq) const {
        const int row0 = u.pm * BM + wr * 64 + fr, cl = wc * 32 + 8 * fq, col0 = u.pn * BM + cl;
        const int mode = (u.pn == 6 || u.pn == 7) ? 1 : (u.pn >= 9 ? 2 : 0);
        float bias[2][8];
#pragma unroll
        for (int bj = 0; bj < 2; ++bj)
#pragma unroll
            for (int j = 0; j < 8; ++j) bias[bj][j] = 0.f;
        if (mode == 2) {
#pragma unroll
            for (int bj = 0; bj < 2; ++bj) { const f32x4 b0 = *(const f32x4*)(gbias + (u.pn - 9) * 256 + cl + bj * HALF), b1 = *(const f32x4*)(gbias + (u.pn - 9) * 256 + cl + bj * HALF + 4);
#pragma unroll
                for (int j = 0; j < 4; ++j) { bias[bj][j] = b0[j]; bias[bj][4 + j] = b1[j]; } }
        }
#pragma unroll
        for (int ai = 0; ai < 2; ++ai)
#pragma unroll
            for (int m = 0; m < 4; ++m) {
                int row = row0 + ai * HALF + m * 16; asm volatile("" : "+v"(row));
                const float rs = rsqrtf(sum16(ss + (size_t)row * 16) * (1.0f / 1024.0f) + EPSF);
                bf16_t* rowp = P + (size_t)row * NIN + col0;
#pragma unroll
                for (int bj = 0; bj < 2; ++bj) {
                    float v[8];
#pragma unroll
                    for (int j = 0; j < 4; ++j) { v[j] = acc[ai][bj][m][0][j] * rs; v[4 + j] = acc[ai][bj][m][1][j] * rs; }
                    if (mode == 1) {
#pragma unroll
                        for (int j = 0; j < 8; ++j) v[j] = gelu_tanh(v[j]);
                    } else if (mode == 2) {
#pragma unroll
                        for (int j = 0; j < 8; ++j) v[j] = logsigmoidf_(v[j] + bias[bj][j]) * (1.0f / 16.0f);
                    }
                    u32x4 w; w.x = cvt_pk_bf16(v[0], v[1]); w.y = cvt_pk_bf16(v[2], v[3]); w.z = cvt_pk_bf16(v[4], v[5]); w.w = cvt_pk_bf16(v[6], v[7]);
                    *(u32x4*)(rowp + bj * HALF) = w;
                }
            }
    }
};
struct EpiRes {
    static constexpr bool PERM = true, AFTER_DRAIN = false;
    const float* xs0; const float* xs1; float* xo; bf16_t* xb; float* ss;
    __device__ __forceinline__ void operator()(const f32x4 (&acc)[2][2][4][2], const Unit& u, int wr, int wc, int fr, int fq) const {
        const int row0 = u.pm * BM + wr * 64 + fr, col0 = u.pn * BM + wc * 32 + 8 * fq;
#pragma unroll
        for (int ai = 0; ai < 2; ++ai)
#pragma unroll
            for (int m = 0; m < 4; ++m) {
                int row = row0 + ai * HALF + m * 16; asm volatile("" : "+v"(row));
                const float* xr = (row < 32768 ? xs0 + (size_t)row * DM : xs1 + (size_t)(row - 32768) * DM) + col0;
                float* xw = xo + (size_t)row * DM + col0; bf16_t* bw = xb + (size_t)row * DM + col0;
                float sq = 0.f;
#pragma unroll
                for (int bj = 0; bj < 2; ++bj) {
                    const f32x4 x0 = *(const f32x4*)(xr + bj * HALF), x1 = *(const f32x4*)(xr + bj * HALF + 4);
                    const f32x4 v0 = acc[ai][bj][m][0] + x0, v1 = acc[ai][bj][m][1] + x1;
                    *(f32x4*)(xw + bj * HALF) = v0; *(f32x4*)(xw + bj * HALF + 4) = v1;
                    u32x4 w; w.x = cvt_pk_bf16(v0[0], v0[1]); w.y = cvt_pk_bf16(v0[2], v0[3]); w.z = cvt_pk_bf16(v1[0], v1[1]); w.w = cvt_pk_bf16(v1[2], v1[3]);
                    *(u32x4*)(bw + bj * HALF) = w;
                    sq += (v0[0] * v0[0] + v0[1] * v0[1]) + (v0[2] * v0[2] + v0[3] * v0[3]) + (v1[0] * v1[0] + v1[1] * v1[1]) + (v1[2] * v1[2] + v1[3] * v1[3]);
                }
                sq += __shfl_xor(sq, 16); sq += __shfl_xor(sq, 32);
                if (fq == 0) ss[(size_t)row * 16 + u.pn * 4 + wc] = sq;
            }
    }
};
struct EpiFfn {
    static constexpr bool PERM = true, AFTER_DRAIN = false;
    bf16_t* act; const float* ss; const float* cw; const float* cb; float* side;
    __device__ __forceinline__ void operator()(const f32x4 (&acc)[2][2][4][2], const Unit& u, int wr, int wc, int fr, int fq) const {
        int lane_l = threadIdx.x & 63; asm volatile("" : "+v"(lane_l)); const int lane = lane_l;
        const int lprev = (lane & 48) | ((fr + 15) & 15), lnext = (lane & 48) | ((fr + 1) & 15);
#pragma unroll
        for (int ai = 0; ai < 2; ++ai) {
            int blk = u.pm * 4 + ai * 2 + wr; asm volatile("" : "+s"(blk));
            const int rbase = blk * 64;
            int ca0 = u.pn * 128 + wc * 32 + 8 * fq; asm volatile("" : "+v"(ca0));
            float rs[4];
#pragma unroll
            for (int m = 0; m < 4; ++m) rs[m] = rsqrtf(sum16(ss + (size_t)(rbase + 16 * m + fr) * 16) * (1.0f / 1024.0f) + EPSF);
            unsigned res[4][4];
            float* sd = side + (size_t)blk * 6 * DFF + ca0;
#pragma unroll
            for (int n = 0; n < 2; ++n) {
                const f32x4 w0 = *(const f32x4*)(cw + ca0 + 4 * n), w1 = *(const f32x4*)(cw + DFF + ca0 + 4 * n), w2 = *(const f32x4*)(cw + 2 * DFF + ca0 + 4 * n), bb = *(const f32x4*)(cb + ca0 + 4 * n);
                float o[4][4];
#pragma unroll
                for (int j = 0; j < 4; ++j) {
                    float a[4], up[4], ps[4], ns[4];
#pragma unroll
                    for (int m = 0; m < 4; ++m) { a[m] = acc[ai][0][m][n][j] * rs[m]; up[m] = acc[ai][1][m][n][j] * rs[m]; }
#pragma unroll
                    for (int m = 0; m < 4; ++m) { ps[m] = __shfl(a[m], lprev); ns[m] = __shfl(a[m], lnext); }
#pragma unroll
                    for (int m = 0; m < 4; ++m) {
                        const float pv = (fr == 0) ? (m > 0 ? ps[m > 0 ? m - 1 : 0] : 0.f) : ps[m];
                        const float nv = (fr == 15) ? (m < 3 ? ns[m < 3 ? m + 1 : 3] : 0.f) : ns[m];
                        const float z = w0[j] * pv + w1[j] * a[m] + w2[j] * nv + bb[j];
                        o[m][j] = siluf_(z) * up[m];
                        if (m == 0 && fr == 0) { sd[4 * n + j] = z; sd[DFF + 4 * n + j] = up[0]; sd[2 * DFF + 4 * n + j] = a[0]; }
                        if (m == 3 && fr == 15) { sd[3 * DFF + 4 * n + j] = z; sd[4 * DFF + 4 * n + j] = up[3]; sd[5 * DFF + 4 * n + j] = a[3]; }
                    }
                }
#pragma unroll
                for (int m = 0; m < 4; ++m) { res[m][2 * n] = cvt_pk_bf16(o[m][0], o[m][1]); res[m][2 * n + 1] = cvt_pk_bf16(o[m][2], o[m][3]); }
            }
#pragma unroll
            for (int m = 0; m < 4; ++m) {
                const bool boundary = (m == 0 && fr == 0) || (m == 3 && fr == 15);
                if (!boundary) { u32x4 w; w.x = res[m][0]; w.y = res[m][1]; w.z = res[m][2]; w.w = res[m][3];
                    *(u32x4*)(act + (size_t)(rbase + 16 * m + fr) * DFF + ca0) = w; }
            }
        }
    }
};

__device__ __forceinline__ bf16x8 lds_frag(LAS unsigned char* lds, int off_bytes) { return *(const LAS bf16x8*)(lds + off_bytes); }
#define MFMA16(a, b, c) __builtin_amdgcn_mfma_f32_16x16x32_bf16((a), (b), (c), 0, 0, 0)
__device__ __forceinline__ void unpack8(const u32x4 w, float (&f)[8]) { f[0] = bflo(w.x); f[1] = bfhi(w.x); f[2] = bflo(w.y); f[3] = bfhi(w.y); f[4] = bflo(w.z); f[5] = bfhi(w.z); f[6] = bflo(w.w); f[7] = bfhi(w.w); }
__device__ __forceinline__ void seq_of(int t, int& s0, int& S) { if (t < 32768) { S = 2048; s0 = t & ~2047; } else { S = 16384; s0 = 32768 + ((t - 32768) & ~16383); } }

__device__ void phase_prep(const Params& p, LAS unsigned char* lds) {
    int tid_l = threadIdx.x; asm volatile("" : "+v"(tid_l)); const int tid = tid_l;
    LAS float* tile = (LAS float*)lds;
    bf16_t* WB = (bf16_t*)(p.ws + OFF_WB);
    constexpr int TPL = 704 + 256 + 1408 + 704;
    for (int it = blockIdx.x; it < TPL * NLAYER; it += gridDim.x) {
        const int l = it / TPL; int r = it % TPL;
        const float* src; int ld; int srccol; const float* gk; bf16_t* dst; int K; int n0, k0; bool comp = false; int cdir = 0, cc0 = 0;
        if (r < 704) { const int nt = r / 16, kt = r % 16; n0 = nt * 64; k0 = kt * 64; K = DM; src = p.w_in + (size_t)l * DM * INW; ld = INW; gk = p.norm1_g + l * DM; dst = WB + l * WB_LAYER + WB_IN;
            if (n0 < 1536) srccol = n0; else if (n0 < 2304) srccol = n0 + 32; else { comp = true; cdir = (n0 - 2304) / 256; cc0 = (n0 - 2304) % 256; srccol = 0; } }
        else if (r < 960) { r -= 704; const int nt = r / 16, kt = r % 16; n0 = nt * 64; k0 = kt * 64; K = DM; src = p.w_o + (size_t)l * DM * DM; ld = DM; gk = nullptr; dst = WB + l * WB_LAYER + WB_O; srccol = n0; }
        else if (r < 2368) { r -= 960; const int nt = r / 16, kt = r % 16; n0 = nt * 64; k0 = kt * 64; K = DM; src = p.w_ffn_in + (size_t)l * DM * 2 * DFF; ld = 2 * DFF; gk = p.norm2_g + l * DM; dst = WB + l * WB_LAYER + WB_1;
            const int pn = n0 / 256, within = n0 % 256; srccol = within < 128 ? pn * 128 + within : DFF + pn * 128 + (within - 128); }
        else { r -= 2368; const int nt = r / 44, kt = r % 44; n0 = nt * 64; k0 = kt * 64; K = DFF; src = p.w_ffn_out + (size_t)l * DFF * DM; ld = DM; gk = nullptr; dst = WB + l * WB_LAYER + WB_2; srccol = n0; }
        if (!comp) {
            const int kk = tid >> 4, nn4 = (tid & 15) * 4;
#pragma unroll
            for (int h = 0; h < 2; ++h) { const int k = kk + 32 * h; const f32x4 v = *(const f32x4*)(src + (size_t)(k0 + k) * ld + srccol + nn4);
                tile[k * 65 + nn4] = v[0]; tile[k * 65 + nn4 + 1] = v[1]; tile[k * 65 + nn4 + 2] = v[2]; tile[k * 65 + nn4 + 3] = v[3]; }
        } else {
            const int kk = tid >> 3, nn8 = (tid & 7) * 8;
            const float* lr = src + (size_t)(k0 + kk) * ld + 1536 + cdir * 16;
            const float* w2 = p.gate_w2 + ((size_t)(l * 2 + cdir) * 16) * 256 + cc0 + nn8;
            float a[8];
#pragma unroll
            for (int j = 0; j < 8; ++j) a[j] = 0.f;
            for (int rr = 0; rr < 16; ++rr) { const float lv = lr[rr]; const f32x4 x0 = *(const f32x4*)(w2 + rr * 256), x1 = *(const f32x4*)(w2 + rr * 256 + 4);
#pragma unroll
                for (int j = 0; j < 4; ++j) { a[j] += lv * x0[j]; a[4 + j] += lv * x1[j]; } }
#pragma unroll
            for (int j = 0; j < 8; ++j) tile[kk * 65 + nn8 + j] = a[j];
        }
        __syncthreads();
        {
            const int nn = tid >> 3, kk8 = (tid & 7) * 8;
            float v[8];
#pragma unroll
            for (int j = 0; j < 8; ++j) v[j] = tile[(kk8 + j) * 65 + nn] * (gk ? gk[k0 + kk8 + j] : 1.0f);
            u32x4 w; w.x = cvt_pk_bf16(v[0], v[1]); w.y = cvt_pk_bf16(v[2], v[3]); w.z = cvt_pk_bf16(v[4], v[5]); w.w = cvt_pk_bf16(v[6], v[7]);
            *(u32x4*)(dst + (size_t)(n0 + nn) * K + k0 + kk8) = w;
        }
        __syncthreads();
    }
    bf16_t* XB = (bf16_t*)(p.ws + OFF_R2); float* SS1 = (float*)(p.ws + OFF_SS1);
    const int wid = tid >> 6, lane = tid & 63;
    for (int row = blockIdx.x * 8 + wid; row < T_TOK; row += gridDim.x * 8) {
        const float* xr = row < 32768 ? p.x_prompt + (size_t)row * DM : p.x_sample + (size_t)(row - 32768) * DM;
        float sq = 0.f;
#pragma unroll
        for (int h = 0; h < 2; ++h) {
            const int c = h * 512 + lane * 8;
            const f32x4 v0 = *(const f32x4*)(xr + c), v1 = *(const f32x4*)(xr + c + 4);
            u32x4 w; w.x = cvt_pk_bf16(v0[0], v0[1]); w.y = cvt_pk_bf16(v0[2], v0[3]); w.z = cvt_pk_bf16(v1[0], v1[1]); w.w = cvt_pk_bf16(v1[2], v1[3]);
            *(u32x4*)(XB + (size_t)row * DM + c) = w;
            sq += (v0[0] * v0[0] + v0[1] * v0[1]) + (v0[2] * v0[2] + v0[3] * v0[3]) + (v1[0] * v1[0] + v1[1] * v1[1]) + (v1[2] * v1[2] + v1[3] * v1[3]);
        }
#pragma unroll
        for (int o = 1; o < 64; o <<= 1) sq += __shfl_xor(sq, o);
        if (lane < 16) SS1[(size_t)row * 16 + lane] = lane == 0 ? sq : 0.f;
    }
}

__device__ __forceinline__ void gla_cumsum(const bf16_t* P, int t0, int h, LAS unsigned char* lds, int gf_off, int gb_off) {
    int tid_l = threadIdx.x; asm volatile("" : "+v"(tid_l)); const int tid = tid_l;
#pragma unroll
    for (int q = 0; q < 2; ++q) {
        const int v = tid + q * 512, dir = v >> 9, rem = v & 511, j = rem >> 3, d8 = (rem & 7) * 8;
        const u32x4 w = *(const u32x4*)(P + (size_t)(t0 + j) * NIN + (dir ? PC_ZB : PC_ZF) + h * 64 + d8);
        float f[8]; unpack8(w, f);
        LAS float* G = (LAS float*)(lds + (dir ? gb_off : gf_off)) + j * 64 + d8;
#pragma unroll
        for (int e = 0; e < 8; ++e) G[e] = f[e];
    }
    __syncthreads();
    if (tid < 128) {
        const int dir = tid >> 6, d = tid & 63;
        LAS float* G = (LAS float*)(lds + (dir ? gb_off : gf_off)) + d;
        float s = 0.f;
        if (dir == 0) { for (int j = 0; j < 64; ++j) { s += G[j * 64]; G[j * 64] = s; } }
        else { for (int j = 63; j >= 0; --j) { s += G[j * 64]; G[j * 64] = s; } }
    }
    __syncthreads();
}

__device__ void phase_m1(const Params& p, LAS unsigned char* lds) {
    int tid_l = threadIdx.x; asm volatile("" : "+v"(tid_l)); const int tid = tid_l, wid = tid >> 6, lane = tid & 63, fr = lane & 15, fq = lane >> 4;
    const bf16_t* P = (const bf16_t*)(p.ws + OFF_R1); bf16_t* KV = (bf16_t*)(p.ws + OFF_R3); float* DEC = (float*)(p.ws + OFF_DEC);
    constexpr int GF = 0, GB = 16384, KTF = 32768, KTB = KTF + 9216, VT = KTB + 9216;
    for (int item = blockIdx.x; item < 4096; item += gridDim.x) {
        const int gc = item >> 2, h = item & 3, t0 = gc * 64;
        gla_cumsum(P, t0, h, lds, GF, GB);
        LAS float* Gf = (LAS float*)(lds + GF); LAS float* Gb = (LAS float*)(lds + GB);
        { const int j = tid >> 3, d8 = (tid & 7) * 8;
            const u32x4 w = *(const u32x4*)(P + (size_t)(t0 + j) * NIN + PC_K + h * 64 + d8); float k[8]; unpack8(w, k);
#pragma unroll
            for (int e = 0; e < 8; ++e) { const int d = d8 + e;
                const float kf = k[e] * __expf(Gf[63 * 64 + d] - Gf[j * 64 + d]), kb = k[e] * __expf(Gb[d] - Gb[j * 64 + d]);
                *(LAS bf16_t*)(lds + KTF + (d * 72 + j) * 2) = f2bf(kf); *(LAS bf16_t*)(lds + KTB + (d * 72 + j) * 2) = f2bf(kb); } }
#pragma unroll
        for (int q = 0; q < 2; ++q) { const int vv = tid + q * 512, j = vv >> 4, v8 = (vv & 15) * 8;
            const u32x4 w = *(const u32x4*)(P + (size_t)(t0 + j) * NIN + PC_V + h * 128 + v8);
            const unsigned ww[4] = {w.x, w.y, w.z, w.w};
#pragma unroll
            for (int e = 0; e < 8; ++e) *(LAS bf16_t*)(lds + VT + ((v8 + e) * 72 + j) * 2) = (bf16_t)((e & 1) ? (ww[e >> 1] >> 16) : (ww[e >> 1] & 0xffffu)); }
        if (tid < 128) { const int dir = tid >> 6, d = tid & 63; DEC[((size_t)item * 2 + dir) * 64 + d] = __expf(dir ? Gb[d] : Gf[63 * 64 + d]); }
        __syncthreads();
        { const int dir = wid >> 2, dt = wid & 3;
            const int abase = (dir ? KTB : KTF) + ((dt * 16 + fr) * 72 + fq * 8) * 2;
            const bf16x8 a0 = lds_frag(lds, abase), a1 = lds_frag(lds, abase + 64);
            bf16_t* dst = KV + ((size_t)item * 2 + dir) * 8192;
#pragma unroll
            for (int vt = 0; vt < 8; ++vt) {
                const int bbase = VT + ((vt * 16 + fr) * 72 + fq * 8) * 2;
                f32x4 c = {0.f, 0.f, 0.f, 0.f};
                c = MFMA16(a0, lds_frag(lds, bbase), c); c = MFMA16(a1, lds_frag(lds, bbase + 64), c);
                u32x2 w; w.x = cvt_pk_bf16(c[0], c[1]); w.y = cvt_pk_bf16(c[2], c[3]);
                *(u32x2*)(dst + (size_t)(vt * 16 + fr) * 64 + dt * 16 + fq * 4) = w;
            } }
        __syncthreads();
    }
}

__device__ void phase_m2(const Params& p) {
    int tid_l = threadIdx.x; asm volatile("" : "+v"(tid_l)); const int tid = tid_l;
    bf16_t* KV = (bf16_t*)(p.ws + OFF_R3); const float* DEC = (const float*)(p.ws + OFF_DEC);
    for (int it = blockIdx.x; it < 576; it += gridDim.x) {
        int sc, slab; if (it < 64) { sc = 128 + (it >> 2); slab = it & 3; } else { sc = (it - 64) >> 2; slab = (it - 64) & 3; }
        const int s = sc >> 3, h = (sc >> 1) & 3, dir = sc & 1;
        const int N = s < 16 ? 32 : 256, gc0 = s < 16 ? s * 32 : 512 + (s - 16) * 256;
        const int e = slab * 2048 + tid * 4, d = e & 63;
        f32x4 st = {0.f, 0.f, 0.f, 0.f};
#pragma unroll 4
        for (int step = 0; step < N; ++step) {
            const int n = dir ? N - 1 - step : step; const size_t idx = ((size_t)(gc0 + n) * 4 + h) * 2 + dir;
            u32x2* ptr = (u32x2*)(KV + idx * 8192 + e);
            const u32x2 w = *ptr; const f32x4 dc = *(const f32x4*)(DEC + idx * 64 + d);
            u32x2 o; o.x = cvt_pk_bf16(st[0], st[1]); o.y = cvt_pk_bf16(st[2], st[3]); *ptr = o;
            st[0] = dc[0] * st[0] + bflo(w.x); st[1] = dc[1] * st[1] + bfhi(w.x); st[2] = dc[2] * st[2] + bflo(w.y); st[3] = dc[3] * st[3] + bfhi(w.y);
        }
    }
}

__device__ void m3_gla(const Params& p, int l, int tb, int h, LAS unsigned char* lds) {
    int tid_l = threadIdx.x; asm volatile("" : "+v"(tid_l)); const int tid = tid_l, wid = tid >> 6, lane = tid & 63, fr = lane & 15, fq = lane >> 4;
    const bf16_t* P = (const bf16_t*)(p.ws + OFF_R1); const bf16_t* KV = (const bf16_t*)(p.ws + OFF_R3); bf16_t* MIX = (bf16_t*)(p.ws + OFF_R2);
    constexpr int GF = 0, GB = 16384, QF = 32768, QB = QF + 9216, KF = QB + 9216, KB = KF + 9216, VT = KB + 9216, PTF = VT + 18432, PTB = PTF + 18432, AT = PTB + 18432, RS = AT + 9216;
    LAS float* Gf = (LAS float*)(lds + GF); LAS float* Gb = (LAS float*)(lds + GB); LAS float* RSS = (LAS float*)(lds + RS);
    const float* ng = p.gla_norm_g + l * 512 + h * 128;
    for (int cc = 0; cc < 2; ++cc) {
        const int gc = tb * 2 + cc, t0 = gc * 64; const size_t item = (size_t)gc * 4 + h;
        gla_cumsum(P, t0, h, lds, GF, GB);
        { const int j = tid >> 3, d8 = (tid & 7) * 8;
            const u32x4 wq = *(const u32x4*)(P + (size_t)(t0 + j) * NIN + PC_Q + h * 64 + d8), wk = *(const u32x4*)(P + (size_t)(t0 + j) * NIN + PC_K + h * 64 + d8);
            float q[8], k[8]; unpack8(wq, q); unpack8(wk, k);
            float qf[8], qb[8], kf[8], kb[8];
#pragma unroll
            for (int e = 0; e < 8; ++e) { const float gf = Gf[j * 64 + d8 + e], gb = Gb[j * 64 + d8 + e]; const float qs = q[e] * 0.125f;
                qf[e] = qs * __expf(gf); qb[e] = qs * __expf(gb); kf[e] = k[e] * __expf(-gf); kb[e] = k[e] * __expf(-gb); }
            const int o = (j * 72 + d8) * 2;
            u32x4 w;
            w.x = cvt_pk_bf16(qf[0], qf[1]); w.y = cvt_pk_bf16(qf[2], qf[3]); w.z = cvt_pk_bf16(qf[4], qf[5]); w.w = cvt_pk_bf16(qf[6], qf[7]); *(LAS u32x4*)(lds + QF + o) = w;
            w.x = cvt_pk_bf16(qb[0], qb[1]); w.y = cvt_pk_bf16(qb[2], qb[3]); w.z = cvt_pk_bf16(qb[4], qb[5]); w.w = cvt_pk_bf16(qb[6], qb[7]); *(LAS u32x4*)(lds + QB + o) = w;
            w.x = cvt_pk_bf16(kf[0], kf[1]); w.y = cvt_pk_bf16(kf[2], kf[3]); w.z = cvt_pk_bf16(kf[4], kf[5]); w.w = cvt_pk_bf16(kf[6], kf[7]); *(LAS u32x4*)(lds + KF + o) = w;
            w.x = cvt_pk_bf16(kb[0], kb[1]); w.y = cvt_pk_bf16(kb[2], kb[3]); w.z = cvt_pk_bf16(kb[4], kb[5]); w.w = cvt_pk_bf16(kb[6], kb[7]); *(LAS u32x4*)(lds + KB + o) = w; }
#pragma unroll
        for (int q = 0; q < 2; ++q) { const int vv = tid + q * 512, j = vv >> 4, v8 = (vv & 15) * 8;
            const u32x4 w = *(const u32x4*)(P + (size_t)(t0 + j) * NIN + PC_V + h * 128 + v8);
            const unsigned ww[4] = {w.x, w.y, w.z, w.w};
#pragma unroll
            for (int e = 0; e < 8; ++e) *(LAS bf16_t*)(lds + VT + ((v8 + e) * 72 + j) * 2) = (bf16_t)((e & 1) ? (ww[e >> 1] >> 16) : (ww[e >> 1] & 0xffffu)); }
#pragma unroll
        for (int q = 0; q < 4; ++q) { const int vv = tid + (q & 1) * 512, dir = q >> 1, v = vv >> 3, d8 = (vv & 7) * 8;
            const u32x4 w = *(const u32x4*)(KV + (item * 2 + dir) * 8192 + v * 64 + d8);
            *(LAS u32x4*)(lds + (dir ? PTB : PTF) + (v * 72 + d8) * 2) = w; }
        __syncthreads();
#pragma unroll
        for (int tt = 0; tt < 2; ++tt) {
            const int tile = wid * 2 + tt, itl = tile >> 2, jt = tile & 3;
            f32x4 cf = {0.f, 0.f, 0.f, 0.f}, cb = {0.f, 0.f, 0.f, 0.f};
            const int ao = ((itl * 16 + fr) * 72 + fq * 8) * 2, bo = ((jt * 16 + fr) * 72 + fq * 8) * 2;
            if (jt <= itl) { cf = MFMA16(lds_frag(lds, QF + ao), lds_frag(lds, KF + bo), cf); cf = MFMA16(lds_frag(lds, QF + ao + 64), lds_frag(lds, KF + bo + 64), cf); }
            if (jt >= itl) { cb = MFMA16(lds_frag(lds, QB + ao), lds_frag(lds, KB + bo), cb); cb = MFMA16(lds_frag(lds, QB + ao + 64), lds_frag(lds, KB + bo + 64), cb); }
            const int j = jt * 16 + fr;
#pragma unroll
            for (int r = 0; r < 4; ++r) { const int i = itl * 16 + fq * 4 + r;
                const float v = (j <= i ? cf[r] : 0.f) + (j >= i ? cb[r] : 0.f);
                *(LAS bf16_t*)(lds + AT + (i * 72 + j) * 2) = f2bf(v); }
        }
        __syncthreads();
        {
            const int itl = wid >> 1, vh = wid & 1;
            const int ao = ((itl * 16 + fr) * 72 + fq * 8) * 2;
            const bf16x8 aA0 = lds_frag(lds, AT + ao), aA1 = lds_frag(lds, AT + ao + 64), aF0 = lds_frag(lds, QF + ao), aF1 = lds_frag(lds, QF + ao + 64), aB0 = lds_frag(lds, QB + ao), aB1 = lds_frag(lds, QB + ao + 64);
            f32x4 o[4]; float sq = 0.f;
#pragma unroll
            for (int q = 0; q < 4; ++q) {
                const int vt = vh * 4 + q, bo = ((vt * 16 + fr) * 72 + fq * 8) * 2;
                f32x4 c = {0.f, 0.f, 0.f, 0.f};
                c = MFMA16(lds_frag(lds, VT + bo), aA0, c); c = MFMA16(lds_frag(lds, VT + bo + 64), aA1, c);
                c = MFMA16(lds_frag(lds, PTF + bo), aF0, c); c = MFMA16(lds_frag(lds, PTF + bo + 64), aF1, c);
                c = MFMA16(lds_frag(lds, PTB + bo), aB0, c); c = MFMA16(lds_frag(lds, PTB + bo + 64), aB1, c);
                o[q] = c; sq += (c[0] * c[0] + c[1] * c[1]) + (c[2] * c[2] + c[3] * c[3]);
            }
            sq += __shfl_xor(sq, 16); sq += __shfl_xor(sq, 32);
            if (fq == 0) RSS[(itl * 16 + fr) * 2 + vh] = sq;
            __syncthreads();
            const int i = itl * 16 + fr; const float rs = rsqrtf((RSS[i * 2] + RSS[i * 2 + 1]) * (1.0f / 128.0f) + EPSF);
            const int t = t0 + i;
#pragma unroll
            for (int q = 0; q < 4; ++q) {
                const int v4 = (vh * 4 + q) * 16 + fq * 4;
                const u32x2 gw = *(const u32x2*)(P + (size_t)t * NIN + PC_G + h * 128 + v4);
                const f32x4 gn = *(const f32x4*)(ng + v4);
                const float g0 = bflo(gw.x), g1 = bfhi(gw.x), g2 = bflo(gw.y), g3 = bfhi(gw.y);
                u32x2 w; w.x = cvt_pk_bf16(o[q][0] * rs * gn[0] * siluf_(g0), o[q][1] * rs * gn[1] * siluf_(g1)); w.y = cvt_pk_bf16(o[q][2] * rs * gn[2] * siluf_(g2), o[q][3] * rs * gn[3] * siluf_(g3));
                *(u32x2*)(MIX + (size_t)t * DM + h * 128 + v4) = w;
            }
        }
        __syncthreads();
    }
}

__device__ void m3_sgu(const Params& p, int l, int tb, LAS unsigned char* lds) {
    int tid_l = threadIdx.x; asm volatile("" : "+v"(tid_l)); const int tid = tid_l, wid = tid >> 6, lane = tid & 63, fr = lane & 15, fq = lane >> 4;
    const bf16_t* P = (const bf16_t*)(p.ws + OFF_R1); bf16_t* MIX = (bf16_t*)(p.ws + OFF_R2);
    constexpr int VT = 0, WS = 256 * 136 * 2;
    const int tbase = tb * 128;
    {
        const f32x4 lg = *(const f32x4*)(p.sgu_ln_g + l * 256 + lane * 4), lb = *(const f32x4*)(p.sgu_ln_b + l * 256 + lane * 4);
        for (int ss = 0; ss < 16; ++ss) {
            const int s = wid * 16 + ss;
            const u32x2 w = *(const u32x2*)(P + (size_t)(tbase + s) * NIN + PC_VS + lane * 4);
            const float x0 = bflo(w.x), x1 = bfhi(w.x), x2 = bflo(w.y), x3 = bfhi(w.y);
            float sm = (x0 + x1) + (x2 + x3);
#pragma unroll
            for (int o = 1; o < 64; o <<= 1) sm += __shfl_xor(sm, o);
            const float mu = sm * (1.0f / 256.0f);
            const float d0 = x0 - mu, d1 = x1 - mu, d2 = x2 - mu, d3 = x3 - mu;
            float vq = (d0 * d0 + d1 * d1) + (d2 * d2 + d3 * d3);
#pragma unroll
            for (int o = 1; o < 64; o <<= 1) vq += __shfl_xor(vq, o);
            const float rstd = rsqrtf(vq * (1.0f / 256.0f) + EPSF);
            *(LAS bf16_t*)(lds + VT + ((lane * 4 + 0) * 136 + s) * 2) = f2bf(d0 * rstd * lg[0] + lb[0]);
            *(LAS bf16_t*)(lds + VT + ((lane * 4 + 1) * 136 + s) * 2) = f2bf(d1 * rstd * lg[1] + lb[1]);
            *(LAS bf16_t*)(lds + VT + ((lane * 4 + 2) * 136 + s) * 2) = f2bf(d2 * rstd * lg[2] + lb[2]);
            *(LAS bf16_t*)(lds + VT + ((lane * 4 + 3) * 136 + s) * 2) = f2bf(d3 * rstd * lg[3] + lb[3]);
        }
    }
    for (int h = 0; h < 4; ++h) {
        const float* wsrc = p.sgu_w + ((size_t)(l * 4 + h) * 128) * 128;
#pragma unroll
        for (int q = 0; q < 8; ++q) { const int vv = tid + q * 512, t = vv >> 5, s4 = (vv & 31) * 4;
            const f32x4 v = *(const f32x4*)(wsrc + t * 128 + s4);
            u32x2 w; w.x = cvt_pk_bf16(v[0], v[1]); w.y = cvt_pk_bf16(v[2], v[3]);
            *(LAS u32x2*)(lds + WS + (t * 136 + s4) * 2) = w; }
        __syncthreads();
        {
            const int ao = WS + ((wid * 16 + fr) * 136 + fq * 8) * 2;
            bf16x8 a[4];
#pragma unroll
            for (int ks = 0; ks < 4; ++ks) a[ks] = lds_frag(lds, ao + ks * 64);
            const int t = tbase + wid * 16 + fr;
            const float bs = p.sgu_b[(l * 4 + h) * 128 + wid * 16 + fr];
#pragma unroll
            for (int ct = 0; ct < 4; ++ct) {
                const int bo = VT + ((h * 64 + ct * 16 + fr) * 136 + fq * 8) * 2;
                f32x4 c = {0.f, 0.f, 0.f, 0.f};
#pragma unroll
                for (int ks = 0; ks < 4; ++ks) c = MFMA16(lds_frag(lds, bo + ks * 64), a[ks], c);
                const int c4 = h * 64 + ct * 16 + fq * 4;
                const u32x2 uw = *(const u32x2*)(P + (size_t)t * NIN + PC_U + c4);
                u32x2 w; w.x = cvt_pk_bf16((c[0] + bs) * bflo(uw.x), (c[1] + bs) * bfhi(uw.x)); w.y = cvt_pk_bf16((c[2] + bs) * bflo(uw.y), (c[3] + bs) * bfhi(uw.y));
                *(u32x2*)(MIX + (size_t)t * DM + 512 + c4) = w;
            }
        }
        __syncthreads();
    }
}

__device__ void m3_pool(const Params& p, int l, int tb, LAS unsigned char* lds) {
    int tid_l = threadIdx.x; asm volatile("" : "+v"(tid_l)); const int tid = tid_l, wid = tid >> 6, lane = tid & 63, fr = lane & 15, fq = lane >> 4;
    const bf16_t* P = (const bf16_t*)(p.ws + OFF_R1); bf16_t* MIX = (bf16_t*)(p.ws + OFF_R2);
    constexpr int XO = 0, DD = 144 * 256 * 2, PW = DD + 128 * 72 * 2;
    const int tbase = tb * 128; int s0, S; seq_of(tbase, s0, S); const int s1 = s0 + S;
#pragma nounroll
    for (int q = 0; q < 9; ++q) { const int vv = tid + q * 512, rl = vv >> 5, c8 = (vv & 31) * 8; const int t = tbase - 8 + rl;
        u32x4 w = {0u, 0u, 0u, 0u};
        if (t >= s0 && t < s1) w = *(const u32x4*)(P + (size_t)t * NIN + PC_XP + c8);
        *(LAS u32x4*)(lds + XO + (rl * 256 + c8) * 2) = w; }
    __syncthreads();
    for (int gi = 0; gi < 4; ++gi) {
        const int hh = 1 << gi;
        { const int c = tid & 63;
#pragma nounroll
            for (int k = 0; k < 16; ++k) { const int tl = (tid >> 6) + 8 * k; const int t = tbase + tl;
                int lo = t - hh; if (lo < s0) lo = s0; int hi = t + hh; if (hi > s1) hi = s1;
                float sm = 0.f;
                for (int r = lo; r < hi; ++r) sm += bf2f(*(LAS bf16_t*)(lds + XO + ((r - tbase + 8) * 256 + gi * 64 + c) * 2));
                const float x = bf2f(*(LAS bf16_t*)(lds + XO + ((tl + 8) * 256 + gi * 64 + c) * 2));
                *(LAS bf16_t*)(lds + DD + (tl * 72 + c) * 2) = f2bf(sm / (float)(hi - lo) - x); } }
        { const float* pw = p.pool_w + ((size_t)(l * 4 + gi) * 64) * 64;
#pragma unroll
            for (int q = 0; q < 8; ++q) { const int vv = tid + q * 512, c = vv >> 6, dd = vv & 63; *(LAS bf16_t*)(lds + PW + (dd * 72 + c) * 2) = f2bf(pw[c * 64 + dd]); } }
        __syncthreads();
        {
            const int ao = DD + ((wid * 16 + fr) * 72 + fq * 8) * 2;
            const bf16x8 a0 = lds_frag(lds, ao), a1 = lds_frag(lds, ao + 64);
            const int t = tbase + wid * 16 + fr;
#pragma unroll
            for (int dt = 0; dt < 4; ++dt) {
                const int bo = PW + ((dt * 16 + fr) * 72 + fq * 8) * 2;
                f32x4 c = {0.f, 0.f, 0.f, 0.f};
                c = MFMA16(lds_frag(lds, bo), a0, c); c = MFMA16(lds_frag(lds, bo + 64), a1, c);
                const int d4 = gi * 64 + dt * 16 + fq * 4;
                const f32x4 sc = *(const f32x4*)(p.pool_scale + l * 256 + d4);
                u32x2 w; w.x = cvt_pk_bf16(c[0] * sc[0], c[1] * sc[1]); w.y = cvt_pk_bf16(c[2] * sc[2], c[3] * sc[3]);
                *(u32x2*)(MIX + (size_t)t * DM + 768 + d4) = w;
            }
        }
        __syncthreads();
    }
}

__device__ void phase_m3(const Params& p, int l, LAS unsigned char* lds) {
#pragma nounroll
    for (int item = blockIdx.x; item < 2048; item += gridDim.x) { m3_gla(p, l, item >> 2, item & 3, lds); }
#pragma nounroll
    for (int item = blockIdx.x; item < 512; item += gridDim.x) { m3_sgu(p, l, item, lds); }
#pragma nounroll
    for (int item = blockIdx.x; item < 512; item += gridDim.x) { m3_pool(p, l, item, lds); }
}

__device__ void phase_fix(const Params& p, int l) {
    bf16_t* ACT = (bf16_t*)(p.ws + OFF_R1); const float* side = (const float*)(p.ws + OFF_R2);
    const float* cw = p.conv_w + (size_t)l * 3 * DFF;
    const int nthr = gridDim.x * 512;
    int tid_l = threadIdx.x; asm volatile("" : "+v"(tid_l));
    for (int i = blockIdx.x * 512 + tid_l; i < 1024 * 2 * (DFF / 4); i += nthr) {
        const int c4 = (i % (DFF / 4)) * 4, rb = i / (DFF / 4), blk = rb >> 1, last = rb & 1;
        const int row = blk * 64 + (last ? 63 : 0);
        int s0, S; seq_of(row, s0, S);
        const float* sb = side + (size_t)blk * 6 * DFF + (last ? 3 * DFF : 0) + c4;
        f32x4 z = *(const f32x4*)sb; const f32x4 up = *(const f32x4*)(sb + DFF);
        if (!last && row != s0) { const f32x4 an = *(const f32x4*)(side + (size_t)(blk - 1) * 6 * DFF + 5 * DFF + c4), w = *(const f32x4*)(cw + c4); z += w * an; }
        if (last && row != s0 + S - 1) { const f32x4 an = *(const f32x4*)(side + (size_t)(blk + 1) * 6 * DFF + 2 * DFF + c4), w = *(const f32x4*)(cw + 2 * DFF + c4); z += w * an; }
        u32x2 o; o.x = cvt_pk_bf16(siluf_(z[0]) * up[0], siluf_(z[1]) * up[1]); o.y = cvt_pk_bf16(siluf_(z[2]) * up[2], siluf_(z[3]) * up[3]);
        *(u32x2*)(ACT + (size_t)row * DFF + c4) = o;
    }
}

__device__ void phase_final(const Params& p) {
    const float* SS1 = (const float*)(p.ws + OFF_SS1);
    int tid_l = threadIdx.x; asm volatile("" : "+v"(tid_l)); const int tid = tid_l, wid = tid >> 6, lane = tid & 63;
    f32x4 g[4];
#pragma unroll
    for (int h = 0; h < 4; ++h) g[h] = *(const f32x4*)(p.norm_f + h * 256 + lane * 4);
    for (int row = blockIdx.x * 8 + wid; row < T_TOK; row += gridDim.x * 8) {
        const float rs = rsqrtf(sum16(SS1 + (size_t)row * 16) * (1.0f / 1024.0f) + EPSF);
        float* xr = p.out + (size_t)row * DM;
#pragma unroll
        for (int h = 0; h < 4; ++h) { f32x4 v = *(const f32x4*)(xr + h * 256 + lane * 4); v = v * rs * g[h];
#ifdef MK_SANITIZE
            for (int j = 0; j < 4; ++j) if (!(fabsf(v[j]) < 1e30f)) v[j] = 100.0f;
#endif
            *(f32x4*)(xr + h * 256 + lane * 4) = v; }
    }
}


#ifndef MK_STOP
#define MK_STOP 99
#endif
__device__ void phase_digest(const Params& p, const bf16_t* a, size_t na, const bf16_t* b, size_t nb, const float* f, size_t nf, bool addout) {
    const size_t n = (size_t)T_TOK * DM;
    for (size_t i = (size_t)blockIdx.x * 512 + threadIdx.x; i < n; i += (size_t)gridDim.x * 512) {
        float v = addout ? p.out[i] : 0.f;
        if (na) { for (size_t k = i; k < na; k += n) v += bf2f(a[k]); }
        if (nb) { for (size_t k = i; k < nb; k += n) v += bf2f(b[k]); }
        if (nf) { for (size_t k = i; k < nf; k += n) v += f[k]; }
        if (!(fabsf(v) < 1e30f)) v = 100.f;
        p.out[i] = v;
    }
}
#define MK_STOP_AT(k, ...) if (MK_STOP == (k) && l == 0) { MK_SYNC(); phase_digest(p, __VA_ARGS__); return; }
#ifndef MK_SYNC
#define MK_SYNC() do { asm volatile("s_waitcnt vmcnt(0)" ::: "memory"); grid.sync(); } while (0)
#endif
__global__ void __launch_bounds__(512, 2) fwd_megakernel(Params p) {
    extern __shared__ __attribute__((aligned(16))) unsigned char shm[];
    LAS unsigned char* lds = (LAS unsigned char*)shm;
    cg::grid_group grid = cg::this_grid();
    bf16_t* WB = (bf16_t*)(p.ws + OFF_WB);
    bf16_t* R1 = (bf16_t*)(p.ws + OFF_R1); bf16_t* R2 = (bf16_t*)(p.ws + OFF_R2); bf16_t* R3 = (bf16_t*)(p.ws + OFF_R3);
    float* SS1 = (float*)(p.ws + OFF_SS1); float* SS2 = (float*)(p.ws + OFF_SS2);
    StaticOrder S;
    phase_prep(p, lds);
    MK_SYNC();
    if (MK_STOP == 0) { phase_digest(p, WB, WB_LAYER * NLAYER, R2, (size_t)T_TOK * DM, SS1, (size_t)T_TOK * 16, false); return; }
    for (int l = 0; l < NLAYER; ++l) {
        const bf16_t* wl = WB + (size_t)l * WB_LAYER;
        { Gemm g{R2, wl + WB_IN, T_TOK, NIN, DM}; S.init(g.M, g.N, (int)gridDim.x, (int)blockIdx.x);
            EpiIn E{R1, SS1, p.gate_b + l * 512};
#ifdef MK_SYNTH_P
            (void)E; (void)g;
            for (size_t i = (size_t)blockIdx.x * 512 + threadIdx.x; i < (size_t)T_TOK * NIN; i += (size_t)gridDim.x * 512) {
                const unsigned hsh = (unsigned)(i * 2654435761ull >> 7) & 1023u; const int col = (int)(i % NIN);
                const float v = col >= PC_ZF ? -(float)hsh * (0.15f / 1024.f) : ((float)hsh - 512.f) * (1.0f / 512.f);
                R1[i] = f2bf(v); }
#else
            gemm_phase<EpiIn, StaticOrder, false>(lds, g, S, E, nullptr);
#endif
            }
        MK_STOP_AT(1, R1, (size_t)T_TOK * NIN, nullptr, 0, nullptr, 0, false)
        MK_SYNC();
        phase_m1(p, lds);
        MK_STOP_AT(2, R3, (size_t)T_TOK * DM, nullptr, 0, (const float*)(p.ws + OFF_DEC), (size_t)8192 * 64, false)
        MK_SYNC();
        phase_m2(p);
        MK_STOP_AT(3, R3, (size_t)T_TOK * DM, nullptr, 0, nullptr, 0, false)
        MK_SYNC();
        phase_m3(p, l, lds);
        MK_STOP_AT(4, R2, (size_t)T_TOK * DM, nullptr, 0, nullptr, 0, false)
        MK_SYNC();
        { Gemm g{R2, wl + WB_O, T_TOK, DM, DM}; S.init(g.M, g.N, (int)gridDim.x, (int)blockIdx.x);
            EpiRes E{l == 0 ? p.x_prompt : p.out, l == 0 ? p.x_sample : p.out + (size_t)32768 * DM, p.out, R3, SS2};
            gemm_phase<EpiRes, StaticOrder, false>(lds, g, S, E, nullptr); }
        MK_STOP_AT(5, R3, (size_t)T_TOK * DM, nullptr, 0, SS2, (size_t)T_TOK * 16, true)
        MK_SYNC();
        { Gemm g{R3, wl + WB_1, T_TOK, 2 * DFF, DM}; S.init(g.M, g.N, (int)gridDim.x, (int)blockIdx.x);
            EpiFfn E{R1, SS2, p.conv_w + (size_t)l * 3 * DFF, p.conv_b + (size_t)l * DFF, (float*)R2};
            gemm_phase<EpiFfn, StaticOrder, false>(lds, g, S, E, nullptr); }
        MK_STOP_AT(6, nullptr, 0, nullptr, 0, (const float*)R2, (size_t)1024 * 6 * DFF, false)
        MK_SYNC();
        phase_fix(p, l);
        MK_STOP_AT(7, R1, (size_t)T_TOK * DFF, nullptr, 0, nullptr, 0, false)
        MK_SYNC();
        { Gemm g{R1, wl + WB_2, T_TOK, DM, DFF}; S.init(g.M, g.N, (int)gridDim.x, (int)blockIdx.x);
            EpiRes E{p.out, p.out + (size_t)32768 * DM, p.out, R2, SS1};
            gemm_phase<EpiRes, StaticOrder, false>(lds, g, S, E, nullptr); }
        MK_STOP_AT(8, R2, (size_t)T_TOK * DM, nullptr, 0, SS1, (size_t)T_TOK * 16, true)
        MK_SYNC();
    }
    phase_final(p);
}

extern "C" void kernel_launch(void* const* d_in, const int* in_sizes, int n_in, void* d_out, int out_size, void* d_ws, size_t ws_size, hipStream_t stream) {
    constexpr size_t kDynLds = 160 * 1024;
    static int grid_blocks = 0;
    if (!grid_blocks) {
        (void)hipFuncSetAttribute((const void*)fwd_megakernel, hipFuncAttributeMaxDynamicSharedMemorySize, (int)kDynLds);
        int dev = 0, cus = 0, per_cu = 0;
        (void)hipGetDevice(&dev);
        (void)hipDeviceGetAttribute(&cus, hipDeviceAttributeMultiprocessorCount, dev);
        (void)hipOccupancyMaxActiveBlocksPerMultiprocessor(&per_cu, fwd_megakernel, 512, kDynLds);
        grid_blocks = cus * per_cu;
        if (grid_blocks > 256) grid_blocks = 256;
    }
    if (ws_size < OFF_END) { fprintf(stderr, "workspace too small\n"); return; }
    Params p{};
    p.x_prompt = (const float*)d_in[0]; p.x_sample = (const float*)d_in[1]; p.norm1_g = (const float*)d_in[2]; p.w_in = (const float*)d_in[3]; p.gate_w2 = (const float*)d_in[4];
    p.gate_b = (const float*)d_in[5]; p.gla_norm_g = (const float*)d_in[6]; p.sgu_ln_g = (const float*)d_in[7]; p.sgu_ln_b = (const float*)d_in[8]; p.sgu_w = (const float*)d_in[9];
    p.sgu_b = (const float*)d_in[10]; p.pool_w = (const float*)d_in[11]; p.pool_scale = (const float*)d_in[12]; p.w_o = (const float*)d_in[13]; p.norm2_g = (const float*)d_in[14];
    p.w_ffn_in = (const float*)d_in[15]; p.conv_w = (const float*)d_in[16]; p.conv_b = (const float*)d_in[17]; p.w_ffn_out = (const float*)d_in[18]; p.norm_f = (const float*)d_in[19];
    p.out = (float*)d_out; p.ws = (unsigned char*)d_ws;
    void* args[] = {&p};
    hipError_t e = hipLaunchCooperativeKernel((void*)fwd_megakernel, dim3(grid_blocks), dim3(512), args, kDynLds, stream);
    if (e != hipSuccess) fprintf(stderr, "cooperative launch failed: %s (grid %d)\n", hipGetErrorString(e), grid_blocks);
}
```

```cpp
#include <hip/hip_runtime.h>
#include <hip/hip_cooperative_groups.h>
#include <cstdio>
namespace cg = cooperative_groups;
namespace pg8 {
#define PG8_LAS __attribute__((address_space(3)))
typedef unsigned short bf16_t;
typedef short bf16x8 __attribute__((ext_vector_type(8)));
typedef float f32x4 __attribute__((ext_vector_type(4)));
typedef unsigned u32x4 __attribute__((ext_vector_type(4)));
constexpr int BM = 256, BK = 64, HALF = 128, HTB = HALF * BK * 2  , STAGE_BYTES = 8 * HTB, NXCD = 8, WGM = 8;

__host__ __device__ __forceinline__ int lds_byte(int r, int c) { const int st = (r >> 4) * 2 + (c >> 5), rr = r & 15, cc = c & 31, ob = rr * 64 + cc * 2; return st * 1024 + (ob ^ (((ob >> 9) & 1) << 5)); }
__host__ __device__ __forceinline__ void stage_rc(int b, int& R, int& C) { const int st = b / 1024, sb = b % 1024, swz = sb ^ (((sb >> 9) & 1) << 5); R = (st >> 1) * 16 + swz / 64; C = (st & 1) * 32 + (swz % 64) / 2; }
__host__ __device__ __forceinline__ int perm32(int rho) { const int n = rho >> 4, i = rho & 15; return 8 * (i >> 2) + 4 * n + (i & 3); }

struct Unit { int pm, pn; };
struct Gemm { const bf16_t* A; const bf16_t* Bt; int M, N, K; };

struct StaticOrder {
    int nM, nN, nwg, G, c;
    __host__ __device__ void init(int M, int N, int G_, int c_) { nM = M / BM; nN = N / BM; nwg = nM * nN; G = G_; c = c_; }
    __host__ __device__ bool next(int i, Unit& u) const {
        const long L = (long)i * G + c; if (L >= nwg) return false;
        int wgid = (int)L; { const int q = nwg / NXCD, r = nwg % NXCD, xcd = wgid % NXCD, off = wgid / NXCD; wgid = (xcd < r ? xcd * (q + 1) : r * (q + 1) + (xcd - r) * q) + off; }
        const int nig = WGM * nN, gid = wgid / nig, fm = gid * WGM, gsz = (nM - fm) < WGM ? (nM - fm) : WGM;
        u.pm = fm + ((wgid % nig) % gsz); u.pn = (wgid % nig) / gsz; return true;
    }
    __device__ __forceinline__ void a_ready(const Unit&) const {}
    __device__ __forceinline__ void done(const Unit&) const {}
};
typedef __bf16 bf16x2_hw __attribute__((ext_vector_type(2)));
typedef float f32x2_hw __attribute__((ext_vector_type(2)));
__device__ __forceinline__ unsigned cvt_pk_bf16(float lo, float hi) { const f32x2_hw v = {lo, hi}; const bf16x2_hw r = __builtin_convertvector(v, bf16x2_hw); return __builtin_bit_cast(unsigned, r); }
template <class Epi, class Sched, bool STAMP = false>
__device__ __forceinline__ void gemm_phase(PG8_LAS unsigned char* lds, const Gemm g, const Sched& S, const Epi& E, unsigned long long* stamps) {
    int tid_l = threadIdx.x; asm volatile("" : "+v"(tid_l));
    const int tid = tid_l, wid = __builtin_amdgcn_readfirstlane(tid >> 6), lane = tid & 63, wr = wid >> 2, wc = wid & 3, fr = lane & 15, fq = lane >> 4;
    const int K = g.K, nt = K / BK;
    int ts_lo = 0, ts_hi = 0, nts = 0; const unsigned long long rt_entry = STAMP ? (unsigned long long)wall_clock64() : 0ull;
#define PG8_STAMP() do { if (STAMP && wid == 0 && nts < 64) { const unsigned long long _c = (unsigned long long)clock64(); \
        ts_lo = (lane == nts) ? (int)(unsigned)_c : ts_lo; ts_hi = (lane == nts) ? (int)(unsigned)(_c >> 32) : ts_hi; ++nts; } } while (0)
    PG8_STAMP();
    unsigned voffA[2], voffB[2];
#pragma unroll
    for (int i = 0; i < 2; ++i) { int R, C; stage_rc(tid * 16 + i * 8192, R, C); const int Rb = Epi::PERM ? ((R & ~31) + perm32(R & 31)) : R;
        voffA[i] = (unsigned)(R * K + C) * 2u; voffB[i] = (unsigned)(Rb * K + C) * 2u; }
    const size_t kstep = (size_t)(BK * 2);
    const size_t hstep = (size_t)HALF * K * 2;
    const size_t tstep = 2 * hstep;
    const unsigned ldsw = (unsigned)wid * 1024u;
    const int aoff = lds_byte(wr * 64 + fr, fq * 8), boff = lds_byte(wc * 32 + fr, fq * 8);
#define PG8_SA(b, h) (((b) * 2 + (h)) * HTB)
#define PG8_SB(b, h) ((4 + (b) * 2 + (h)) * HTB)
#define PG8_STAGE(bufoff, gbase, voff) do { _Pragma("unroll") for (int _i = 0; _i < 2; ++_i) \
        __builtin_amdgcn_global_load_lds((const unsigned*)((const char*)(gbase) + (voff)[_i]), (PG8_LAS unsigned*)(lds + (bufoff) + ldsw + _i * 8192), 16, 0, 0); } while (0)
#define PG8_LDA(dst, b, h) do { _Pragma("unroll") for (int m = 0; m < 4; ++m) _Pragma("unroll") for (int k = 0; k < 2; ++k) dst[m][k] = *(const PG8_LAS bf16x8*)(lds + PG8_SA(b, h) + aoff + m * 2048 + k * 1024); } while (0)
#define PG8_LDB(dst, b, h) do { _Pragma("unroll") for (int n = 0; n < 2; ++n) _Pragma("unroll") for (int k = 0; k < 2; ++k) dst[n][k] = *(const PG8_LAS bf16x8*)(lds + PG8_SB(b, h) + boff + n * 2048 + k * 1024); } while (0)
#define PG8_MMA(ai, bj, At, Bt) do { __builtin_amdgcn_s_setprio(1); _Pragma("unroll") for (int m = 0; m < 4; ++m) _Pragma("unroll") for (int n = 0; n < 2; ++n) _Pragma("unroll") for (int k = 0; k < 2; ++k) \
        acc[ai][bj][m][n] = __builtin_amdgcn_mfma_f32_16x16x32_bf16(Bt[n][k], At[m][k], acc[ai][bj][m][n], 0, 0, 0); __builtin_amdgcn_s_setprio(0); } while (0)
#define PG8_WAIT_V(n) asm volatile("s_waitcnt vmcnt(" #n ")" ::: "memory")
#define PG8_WAIT_L(n) asm volatile("s_waitcnt lgkmcnt(" #n ")" ::: "memory")
#define PG8_BAR __builtin_amdgcn_s_barrier()
#define PG8_SCHED __builtin_amdgcn_sched_barrier(0)
    Unit cur, nxt; int ui = 0;
    if (!S.next(0, cur)) return;
    f32x4 acc[2][2][4][2];
#pragma unroll
    for (int a = 0; a < 2; ++a)
#pragma unroll
        for (int b = 0; b < 2; ++b)
#pragma unroll
            for (int m = 0; m < 4; ++m)
#pragma unroll
                for (int n = 0; n < 2; ++n) acc[a][b][m][n] = (f32x4){0.f, 0.f, 0.f, 0.f};
    bf16x8 At[4][2], B0[2][2], B1[2][2];
    const char* cA = (const char*)g.A + (size_t)cur.pm * tstep; const char* cB = (const char*)g.Bt + (size_t)cur.pn * tstep;
    S.a_ready(cur);
    PG8_STAGE(PG8_SB(0, 0), cB, voffB); PG8_STAGE(PG8_SA(0, 0), cA, voffA); PG8_STAGE(PG8_SB(0, 1), cB + hstep, voffB); PG8_STAGE(PG8_SA(0, 1), cA + hstep, voffA);
    if (wr == 1) PG8_BAR;
    PG8_WAIT_V(4); PG8_BAR;
    PG8_STAGE(PG8_SB(1, 0), cB + kstep, voffB); PG8_STAGE(PG8_SA(1, 0), cA + kstep, voffA); PG8_STAGE(PG8_SB(1, 1), cB + hstep + kstep, voffB);
    PG8_WAIT_V(6); PG8_BAR;
    PG8_STAMP();
    for (;;) {
        const bool has_next = S.next(ui + 1, nxt);
        const char* nA = has_next ? (const char*)g.A + (size_t)nxt.pm * tstep : cA; const char* nB = has_next ? (const char*)g.Bt + (size_t)nxt.pn * tstep : cB;
        for (int t = 0; t < nt; t += 2) {
            const bool last = (t == nt - 2);
            const char* a1 = cA + (size_t)(t + 1) * kstep;
            const char* a2 = last ? nA : cA + (size_t)(t + 2) * kstep; const char* b2 = last ? nB : cB + (size_t)(t + 2) * kstep;
            const char* a3 = a2 + kstep; const char* b3 = b2 + kstep;
            if (last && has_next) S.a_ready(nxt);
            PG8_LDB(B0, 0, 0); PG8_SCHED; PG8_LDA(At, 0, 0); PG8_STAGE(PG8_SA(1, 1), a1 + hstep, voffA);
            PG8_WAIT_L(8); PG8_BAR; PG8_WAIT_L(0); PG8_MMA(0, 0, At, B0); PG8_BAR; PG8_SCHED;
            PG8_LDB(B1, 0, 1); PG8_STAGE(PG8_SB(0, 0), b2, voffB);
            PG8_BAR; PG8_WAIT_L(0); PG8_MMA(0, 1, At, B1); PG8_BAR;
            PG8_LDA(At, 0, 1); PG8_STAGE(PG8_SA(0, 0), a2, voffA);
            PG8_BAR; PG8_WAIT_L(0); PG8_MMA(1, 0, At, B0); PG8_BAR; PG8_SCHED;
            PG8_STAGE(PG8_SB(0, 1), b2 + hstep, voffB);
            PG8_WAIT_V(6); PG8_BAR; PG8_MMA(1, 1, At, B1); PG8_BAR;
            PG8_LDB(B0, 1, 0); PG8_SCHED; PG8_LDA(At, 1, 0); PG8_STAGE(PG8_SA(0, 1), a2 + hstep, voffA);
            PG8_WAIT_L(8); PG8_BAR; PG8_WAIT_L(0); PG8_MMA(0, 0, At, B0); PG8_BAR; PG8_SCHED;
            PG8_LDB(B1, 1, 1); PG8_STAGE(PG8_SB(1, 0), b3, voffB);
            PG8_BAR; PG8_WAIT_L(0); PG8_MMA(0, 1, At, B1); PG8_BAR;
            PG8_LDA(At, 1, 1); PG8_STAGE(PG8_SA(1, 0), a3, voffA);
            PG8_BAR; PG8_WAIT_L(0); PG8_MMA(1, 0, At, B0); PG8_BAR; PG8_SCHED;
            PG8_STAGE(PG8_SB(1, 1), b3 + hstep, voffB);
            PG8_WAIT_V(6); PG8_BAR; PG8_MMA(1, 1, At, B1); PG8_BAR;
        }
        PG8_STAMP();
        if constexpr (!Epi::AFTER_DRAIN) { E(acc, cur, ui, lds, wr, wc, fr, fq); S.done(cur); }
        PG8_STAMP();
        if (!has_next) break;
#pragma unroll
        for (int a = 0; a < 2; ++a)
#pragma unroll
            for (int b = 0; b < 2; ++b)
#pragma unroll
                for (int m = 0; m < 4; ++m)
#pragma unroll
                    for (int n = 0; n < 2; ++n) acc[a][b][m][n] = (f32x4){0.f, 0.f, 0.f, 0.f};
        cur = nxt; cA = nA; cB = nB; ++ui;
    }
    PG8_WAIT_V(0);
    if (wr == 0) PG8_BAR;
    PG8_BAR;
    if constexpr (Epi::AFTER_DRAIN) { E.fused(acc, cur, wr, wc, fr, fq, lds, wid, lane); S.done(cur); }
    PG8_STAMP();
    if (STAMP && wid == 0) { stamps[lane] = lane < nts ? (((unsigned long long)(unsigned)ts_hi << 32) | (unsigned)ts_lo) : 0ull;
        if (lane == 62) stamps[62] = rt_entry; if (lane == 63) stamps[63] = (unsigned long long)wall_clock64(); }
#undef PG8_STAMP
#undef PG8_SA
#undef PG8_SB
#undef PG8_STAGE
#undef PG8_LDA
#undef PG8_LDB
#undef PG8_MMA
#undef PG8_WAIT_V
#undef PG8_WAIT_L
#undef PG8_BAR
#undef PG8_SCHED
}
}
using namespace pg8;
typedef unsigned u32x2 __attribute__((ext_vector_type(2)));
typedef float f32x2v __attribute__((ext_vector_type(2)));
#define LAS PG8_LAS

constexpr int T_TOK = 65536, DM = 1024, NIN = 2816, DFF = 2816, NLAYER = 4, INW = 2336;
constexpr int PC_Q = 0, PC_K = 256, PC_V = 512, PC_G = 1024, PC_XP = 1536, PC_U = 1792, PC_VS = 2048, PC_ZF = 2304, PC_ZB = 2560;
constexpr float EPSF = 1e-6f;
__device__ __forceinline__ size_t kv_idx(int gc, int h, int dir) { return (size_t)(h * 2 + dir) * 1024 + gc; }
constexpr size_t WB_IN = 0, WB_O = (size_t)NIN * DM, WB_1 = WB_O + (size_t)DM * DM, WB_2 = WB_1 + (size_t)2 * DFF * DM, WB_LAYER = WB_2 + (size_t)DM * DFF;
constexpr size_t OFF_WB = 0;
constexpr size_t OFF_R1 = OFF_WB + WB_LAYER * 2 * NLAYER;
constexpr size_t OFF_R2 = OFF_R1 + (size_t)T_TOK * NIN * 2;
constexpr size_t OFF_R3 = OFF_R2 + (size_t)T_TOK * DM * 2;
constexpr size_t OFF_SS1 = OFF_R3 + (size_t)T_TOK * DM * 2;
constexpr size_t OFF_SS2 = OFF_SS1 + (size_t)T_TOK * 16 * 4;
constexpr size_t OFF_DEC = OFF_SS2 + (size_t)T_TOK * 16 * 4;
constexpr size_t OFF_BAR = OFF_DEC + (size_t)8192 * 64 * 4;
constexpr size_t OFF_END = OFF_BAR + 16384;

struct Params {
    const float* x_prompt; const float* x_sample; const float* norm1_g; const float* w_in; const float* gate_w2; const float* gate_b; const float* gla_norm_g;
    const float* sgu_ln_g; const float* sgu_ln_b; const float* sgu_w; const float* sgu_b; const float* pool_w; const float* pool_scale; const float* w_o; const float* norm2_g;
    const float* w_ffn_in; const float* conv_w; const float* conv_b; const float* w_ffn_out; const float* norm_f;
    float* out; unsigned char* ws;
};

__device__ __forceinline__ unsigned short f2bf(float f) { return (unsigned short)cvt_pk_bf16(f, 0.f); }
__device__ __forceinline__ float bf2f(unsigned short b) { return __uint_as_float(((unsigned)b) << 16); }
__device__ __forceinline__ float bflo(unsigned w) { return __uint_as_float(w << 16); }
__device__ __forceinline__ float bfhi(unsigned w) { return __uint_as_float(w & 0xffff0000u); }
__device__ __forceinline__ float siluf_(float x) { return x * __builtin_amdgcn_rcpf(1.0f + __builtin_amdgcn_exp2f(-1.44269504f * x)); }
__device__ __forceinline__ float gelu_tanh(float x) { const float y = x * (2.30220819f + 0.10294324f * x * x); return x * __builtin_amdgcn_rcpf(1.0f + __builtin_amdgcn_exp2f(-y)); }
__device__ __forceinline__ float logsigmoidf_(float z) { return fminf(z, 0.f) - 0.69314718f * __builtin_amdgcn_logf(1.0f + __builtin_amdgcn_exp2f(-1.44269504f * fabsf(z))); }
__device__ __forceinline__ float sum16(const float* p) { const f32x4 a = *(const f32x4*)p, b = *(const f32x4*)(p + 4), c = *(const f32x4*)(p + 8), d = *(const f32x4*)(p + 12);
    return ((a[0] + a[1]) + (a[2] + a[3])) + ((b[0] + b[1]) + (b[2] + b[3])) + ((c[0] + c[1]) + (c[2] + c[3])) + ((d[0] + d[1]) + (d[2] + d[3])); }

__device__ __forceinline__ void unpack8(const u32x4 w, float (&f)[8]) { f[0] = bflo(w.x); f[1] = bfhi(w.x); f[2] = bflo(w.y); f[3] = bfhi(w.y); f[4] = bflo(w.z); f[5] = bfhi(w.z); f[6] = bflo(w.w); f[7] = bfhi(w.w); }
constexpr int RS_LDS = 131072;
template <class Sched> __device__ __forceinline__ void precompute_rs(LAS unsigned char* lds, const Sched& S, const float* ss, int slot0 = 0, bool sync = true) {
    int tid_l = threadIdx.x; asm volatile("" : "+v"(tid_l)); const int tid = tid_l;
    Unit u; int nU = 0;
    while (S.next(nU, u)) ++nU;
    const int r = tid & 255;
#pragma unroll 4
    for (int i = tid >> 8; i < nU; i += 2) { S.next(i, u);
        const float t = sum16(ss + (size_t)(u.pm * BM + r) * 16); *(LAS float*)(lds + RS_LDS + ((slot0 + i) * 256 + r) * 4) = rsqrtf(t * (1.0f / 1024.0f) + EPSF); }
    if (sync) __syncthreads();
}
template <int MODE  > struct EpiIn {
    static constexpr bool PERM = true, AFTER_DRAIN = false;
    bf16_t* P; const float* gbias; int colbase, slot0;
    __device__ __forceinline__ void operator()(const f32x4 (&acc)[2][2][4][2], const Unit& u, int ui, LAS unsigned char* lds, int wr, int wc, int fr, int fq) const {
        const int row0 = u.pm * BM + wr * 64 + fr, cl = wc * 32 + 8 * fq, col0 = colbase + u.pn * BM + cl;
        float bias[2][8];
#pragma unroll
        for (int bj = 0; bj < 2; ++bj)
#pragma unroll
            for (int j = 0; j < 8; ++j) bias[bj][j] = 0.f;
        if (MODE == 2) {
#pragma unroll
            for (int bj = 0; bj < 2; ++bj) { const f32x4 b0 = *(const f32x4*)(gbias + u.pn * 256 + cl + bj * HALF), b1 = *(const f32x4*)(gbias + u.pn * 256 + cl + bj * HALF + 4);
#pragma unroll
                for (int j = 0; j < 4; ++j) { bias[bj][j] = b0[j]; bias[bj][4 + j] = b1[j]; } }
        }
        float rsv[8];
#pragma unroll
        for (int it = 0; it < 8; ++it) rsv[it] = *(const LAS float*)(lds + RS_LDS + ((slot0 + ui) * 256 + wr * 64 + fr + (it >> 2) * HALF + (it & 3) * 16) * 4);
#pragma unroll
        for (int ai = 0; ai < 2; ++ai)
#pragma unroll
            for (int m = 0; m < 4; ++m) {
                int row = row0 + ai * HALF + m * 16; asm volatile("" : "+v"(row));
                const float rs = rsv[ai * 4 + m];
                bf16_t* rowp = P + (size_t)row * NIN + col0;
#pragma unroll
                for (int bj = 0; bj < 2; ++bj) {
                    float v[8];
#pragma unroll
                    for (int j = 0; j < 4; ++j) { v[j] = acc[ai][bj][m][0][j] * rs; v[4 + j] = acc[ai][bj][m][1][j] * rs; }
                    if (MODE == 1) {
#pragma unroll
                        for (int j = 0; j < 8; ++j) v[j] = gelu_tanh(v[j]);
                    } else if (MODE == 2) {
#pragma unroll
                        for (int j = 0; j < 8; ++j) v[j] = logsigmoidf_(v[j] + bias[bj][j]) * (1.44269504f / 16.0f);
                    }
                    u32x4 w; w.x = cvt_pk_bf16(v[0], v[1]); w.y = cvt_pk_bf16(v[2], v[3]); w.z = cvt_pk_bf16(v[4], v[5]); w.w = cvt_pk_bf16(v[6], v[7]);
                    *(u32x4*)(rowp + bj * HALF) = w;
                }
            }
    }
};
struct EpiRes {
    static constexpr bool PERM = true, AFTER_DRAIN = false;
    const bf16_t* xs; bf16_t* xb; float* ss;
    __device__ __forceinline__ void operator()(const f32x4 (&acc)[2][2][4][2], const Unit& u, int ui, LAS unsigned char* lds, int wr, int wc, int fr, int fq) const {
        const int row0 = u.pm * BM + wr * 64 + fr, col0 = u.pn * BM + wc * 32 + 8 * fq;
        u32x4 xc[2], xn[2];
        { int row = row0; asm volatile("" : "+v"(row)); const bf16_t* xr = xs + (size_t)row * DM + col0; xc[0] = *(const u32x4*)(xr); xc[1] = *(const u32x4*)(xr + HALF); }
#pragma unroll
        for (int it = 0; it < 8; ++it) {
            const int ai = it >> 2, m = it & 3;
            if (it < 7) { int rown = row0 + ((it + 1) >> 2) * HALF + ((it + 1) & 3) * 16; asm volatile("" : "+v"(rown)); const bf16_t* xr = xs + (size_t)rown * DM + col0;
                xn[0] = *(const u32x4*)(xr); xn[1] = *(const u32x4*)(xr + HALF); }
            int row = row0 + ai * HALF + m * 16; asm volatile("" : "+v"(row));
            bf16_t* bw = xb + (size_t)row * DM + col0;
            float sq = 0.f;
#pragma unroll
            for (int bj = 0; bj < 2; ++bj) {
                float x[8]; unpack8(xc[bj], x);
                u32x4 w;
                w.x = cvt_pk_bf16(acc[ai][bj][m][0][0] + x[0], acc[ai][bj][m][0][1] + x[1]); w.y = cvt_pk_bf16(acc[ai][bj][m][0][2] + x[2], acc[ai][bj][m][0][3] + x[3]);
                w.z = cvt_pk_bf16(acc[ai][bj][m][1][0] + x[4], acc[ai][bj][m][1][1] + x[5]); w.w = cvt_pk_bf16(acc[ai][bj][m][1][2] + x[6], acc[ai][bj][m][1][3] + x[7]);
                *(u32x4*)(bw + bj * HALF) = w;
                float r[8]; unpack8(w, r);
                sq += (r[0] * r[0] + r[1] * r[1]) + (r[2] * r[2] + r[3] * r[3]) + (r[4] * r[4] + r[5] * r[5]) + (r[6] * r[6] + r[7] * r[7]);
            }
            sq += __shfl_xor(sq, 16); sq += __shfl_xor(sq, 32);
            if (fq == 0) ss[(size_t)row * 16 + u.pn * 4 + wc] = sq;
            xc[0] = xn[0]; xc[1] = xn[1];
        }
    }
};
__device__ __forceinline__ float dpp_prev(float x) { return __builtin_bit_cast(float, __builtin_amdgcn_update_dpp(0, __builtin_bit_cast(int, x), 0x121, 0xf, 0xf, false)); }
__device__ __forceinline__ float dpp_next(float x) { return __builtin_bit_cast(float, __builtin_amdgcn_update_dpp(0, __builtin_bit_cast(int, x), 0x12F, 0xf, 0xf, false)); }
struct EpiFfn {
    static constexpr bool PERM = true, AFTER_DRAIN = false;
    bf16_t* act; const float* ss; const float* cw; const float* cb; float* side;
    __device__ __forceinline__ void operator()(const f32x4 (&acc)[2][2][4][2], const Unit& u, int ui, LAS unsigned char* lds, int wr, int wc, int fr, int fq) const {
#pragma unroll
        for (int ai = 0; ai < 2; ++ai) {
            int blk = u.pm * 4 + ai * 2 + wr; asm volatile("" : "+s"(blk));
            const int rbase = blk * 64;
            int ca0 = u.pn * 128 + wc * 32 + 8 * fq; asm volatile("" : "+v"(ca0));
            float rs[4];
#pragma unroll
            for (int m = 0; m < 4; ++m) rs[m] = *(const LAS float*)(lds + RS_LDS + (ui * 256 + ai * HALF + wr * 64 + 16 * m + fr) * 4);
            float* sd = side + (size_t)blk * 6 * DFF + ca0;
#pragma unroll
            for (int n = 0; n < 2; ++n) {
                const f32x4 w0 = *(const f32x4*)(cw + ca0 + 4 * n), w1 = *(const f32x4*)(cw + DFF + ca0 + 4 * n), w2 = *(const f32x4*)(cw + 2 * DFF + ca0 + 4 * n), bb = *(const f32x4*)(cb + ca0 + 4 * n);
                unsigned pk[4][2];
#pragma unroll
                for (int jp = 0; jp < 2; ++jp) {
                    const f32x2v w0v = {w0[2 * jp], w0[2 * jp + 1]}, w1v = {w1[2 * jp], w1[2 * jp + 1]}, w2v = {w2[2 * jp], w2[2 * jp + 1]}, bbv = {bb[2 * jp], bb[2 * jp + 1]};
                    f32x2v a[4], up[4], ps[4], ns[4];
#pragma unroll
                    for (int m = 0; m < 4; ++m) { a[m] = (f32x2v){acc[ai][0][m][n][2 * jp], acc[ai][0][m][n][2 * jp + 1]} * rs[m]; up[m] = (f32x2v){acc[ai][1][m][n][2 * jp], acc[ai][1][m][n][2 * jp + 1]} * rs[m]; }
#pragma unroll
                    for (int m = 0; m < 4; ++m) { ps[m].x = dpp_prev(a[m].x); ps[m].y = dpp_prev(a[m].y); ns[m].x = dpp_next(a[m].x); ns[m].y = dpp_next(a[m].y); }
#pragma unroll
                    for (int m = 0; m < 4; ++m) {
                        const f32x2v zero = {0.f, 0.f};
                        const f32x2v pv = (fr == 0) ? (m > 0 ? ps[m > 0 ? m - 1 : 0] : zero) : ps[m];
                        const f32x2v nv = (fr == 15) ? (m < 3 ? ns[m < 3 ? m + 1 : 3] : zero) : ns[m];
                        const f32x2v z = w0v * pv + (w1v * a[m] + (w2v * nv + bbv));
                        const f32x2v t = z * (-1.44269504f);
                        f32x2v e; e.x = __builtin_amdgcn_exp2f(t.x); e.y = __builtin_amdgcn_exp2f(t.y);
                        const f32x2v d = e + 1.0f;
                        f32x2v r; r.x = __builtin_amdgcn_rcpf(d.x); r.y = __builtin_amdgcn_rcpf(d.y);
                        const f32x2v o = (z * r) * up[m];
                        pk[m][jp] = cvt_pk_bf16(o.x, o.y);
                        if (m == 0 && fr == 0) { *(f32x2v*)(sd + 4 * n + 2 * jp) = z; *(f32x2v*)(sd + DFF + 4 * n + 2 * jp) = up[0]; *(f32x2v*)(sd + 2 * DFF + 4 * n + 2 * jp) = a[0]; }
                        if (m == 3 && fr == 15) { *(f32x2v*)(sd + 3 * DFF + 4 * n + 2 * jp) = z; *(f32x2v*)(sd + 4 * DFF + 4 * n + 2 * jp) = up[3]; *(f32x2v*)(sd + 5 * DFF + 4 * n + 2 * jp) = a[3]; }
                    }
                }
#pragma unroll
                for (int m = 0; m < 4; ++m) {
                    const bool boundary = (m == 0 && fr == 0) || (m == 3 && fr == 15);
                    if (!boundary) { u32x2 w; w.x = pk[m][0]; w.y = pk[m][1]; *(u32x2*)(act + (size_t)(rbase + 16 * m + fr) * DFF + ca0 + 4 * n) = w; }
                }
            }
        }
    }
};

__device__ __forceinline__ bf16x8 lds_frag(LAS unsigned char* lds, int off_bytes) { return *(const LAS bf16x8*)(lds + off_bytes); }
#define MFMA16(a, b, c) __builtin_amdgcn_mfma_f32_16x16x32_bf16((a), (b), (c), 0, 0, 0)
__device__ __forceinline__ void seq_of(int t, int& s0, int& S) { if (t < 32768) { S = 2048; s0 = t & ~2047; } else { S = 16384; s0 = 32768 + ((t - 32768) & ~16383); } }

__device__ void phase_prep(const Params& p, LAS unsigned char* lds) {
    int tid_l = threadIdx.x; asm volatile("" : "+v"(tid_l)); const int tid = tid_l;
    LAS float* tile = (LAS float*)lds;
    bf16_t* WB = (bf16_t*)(p.ws + OFF_WB);
    constexpr int TPL = 704 + 256 + 1408 + 704;
    for (int it = blockIdx.x; it < TPL * NLAYER; it += gridDim.x) {
        const int l = it / TPL; int r = it % TPL;
        const float* src; int ld; int srccol; const float* gk; bf16_t* dst; int K; int n0, k0; bool comp = false; int cdir = 0, cc0 = 0;
        if (r < 704) { const int nt = r / 16, kt = r % 16; n0 = nt * 64; k0 = kt * 64; K = DM; src = p.w_in + (size_t)l * DM * INW; ld = INW; gk = p.norm1_g + l * DM; dst = WB + l * WB_LAYER + WB_IN;
            if (n0 < 1536) srccol = n0; else if (n0 < 1792) srccol = n0 + 544; else if (n0 < 2304) srccol = n0 - 224; else { comp = true; cdir = (n0 - 2304) / 256; cc0 = (n0 - 2304) % 256; srccol = 0; } }
        else if (r < 960) { r -= 704; const int nt = r / 16, kt = r % 16; n0 = nt * 64; k0 = kt * 64; K = DM; src = p.w_o + (size_t)l * DM * DM; ld = DM; gk = nullptr; dst = WB + l * WB_LAYER + WB_O; srccol = n0; }
        else if (r < 2368) { r -= 960; const int nt = r / 16, kt = r % 16; n0 = nt * 64; k0 = kt * 64; K = DM; src = p.w_ffn_in + (size_t)l * DM * 2 * DFF; ld = 2 * DFF; gk = p.norm2_g + l * DM; dst = WB + l * WB_LAYER + WB_1;
            const int pn = n0 / 256, within = n0 % 256; srccol = within < 128 ? pn * 128 + within : DFF + pn * 128 + (within - 128); }
        else { r -= 2368; const int nt = r / 44, kt = r % 44; n0 = nt * 64; k0 = kt * 64; K = DFF; src = p.w_ffn_out + (size_t)l * DFF * DM; ld = DM; gk = nullptr; dst = WB + l * WB_LAYER + WB_2; srccol = n0; }
        if (!comp) {
            const int kk = tid >> 4, nn4 = (tid & 15) * 4;
#pragma unroll
            for (int h = 0; h < 2; ++h) { const int k = kk + 32 * h; const f32x4 v = __builtin_nontemporal_load((const f32x4*)(src + (size_t)(k0 + k) * ld + srccol + nn4));
                tile[k * 65 + nn4] = v[0]; tile[k * 65 + nn4 + 1] = v[1]; tile[k * 65 + nn4 + 2] = v[2]; tile[k * 65 + nn4 + 3] = v[3]; }
        } else {
            const int kk = tid >> 3, nn8 = (tid & 7) * 8;
            const float* lr = src + (size_t)(k0 + kk) * ld + 1536 + cdir * 16;
            const float* w2 = p.gate_w2 + ((size_t)(l * 2 + cdir) * 16) * 256 + cc0 + nn8;
            float a[8];
#pragma unroll
            for (int j = 0; j < 8; ++j) a[j] = 0.f;
            for (int rr = 0; rr < 16; ++rr) { const float lv = lr[rr]; const f32x4 x0 = *(const f32x4*)(w2 + rr * 256), x1 = *(const f32x4*)(w2 + rr * 256 + 4);
#pragma unroll
                for (int j = 0; j < 4; ++j) { a[j] += lv * x0[j]; a[4 + j] += lv * x1[j]; } }
#pragma unroll
            for (int j = 0; j < 8; ++j) tile[kk * 65 + nn8 + j] = a[j];
        }
        __syncthreads();
        {
            const int nn = tid >> 3, kk8 = (tid & 7) * 8;
            float v[8];
#pragma unroll
            for (int j = 0; j < 8; ++j) v[j] = tile[(kk8 + j) * 65 + nn] * (gk ? gk[k0 + kk8 + j] : 1.0f);
            u32x4 w; w.x = cvt_pk_bf16(v[0], v[1]); w.y = cvt_pk_bf16(v[2], v[3]); w.z = cvt_pk_bf16(v[4], v[5]); w.w = cvt_pk_bf16(v[6], v[7]);
            *(u32x4*)(dst + (size_t)(n0 + nn) * K + k0 + kk8) = w;
        }
        __syncthreads();
    }
    bf16_t* XB = (bf16_t*)p.out; float* SS1 = (float*)(p.ws + OFF_SS1);
    const int wid = tid >> 6, lane = tid & 63;
    for (int row0 = (blockIdx.x * 8 + wid) * 4; row0 < T_TOK; row0 += gridDim.x * 32) {
        f32x4 v[4][4];
#pragma unroll
        for (int r = 0; r < 4; ++r) { const int row = row0 + r; const float* xr = row < 32768 ? p.x_prompt + (size_t)row * DM : p.x_sample + (size_t)(row - 32768) * DM;
#pragma unroll
            for (int h = 0; h < 2; ++h) { v[r][2 * h] = __builtin_nontemporal_load((const f32x4*)(xr + h * 512 + lane * 8)); v[r][2 * h + 1] = __builtin_nontemporal_load((const f32x4*)(xr + h * 512 + lane * 8 + 4)); } }
#pragma unroll
        for (int r = 0; r < 4; ++r) { const int row = row0 + r;
            float sq = 0.f;
#pragma unroll
            for (int h = 0; h < 2; ++h) {
                const f32x4 v0 = v[r][2 * h], v1 = v[r][2 * h + 1];
                u32x4 w; w.x = cvt_pk_bf16(v0[0], v0[1]); w.y = cvt_pk_bf16(v0[2], v0[3]); w.z = cvt_pk_bf16(v1[0], v1[1]); w.w = cvt_pk_bf16(v1[2], v1[3]);
                *(u32x4*)(XB + (size_t)row * DM + h * 512 + lane * 8) = w;
                float q[8]; unpack8(w, q);
                sq += (q[0] * q[0] + q[1] * q[1]) + (q[2] * q[2] + q[3] * q[3]) + (q[4] * q[4] + q[5] * q[5]) + (q[6] * q[6] + q[7] * q[7]);
            }
#pragma unroll
            for (int o = 1; o < 64; o <<= 1) sq += __shfl_xor(sq, o);
            if (lane < 16) SS1[(size_t)row * 16 + lane] = lane == 0 ? sq : 0.f;
        }
    }
}

template <int CTRL, int ROWMASK, bool BOUND> __device__ __forceinline__ float dpp_add(float v) {
    return v + __builtin_bit_cast(float, __builtin_amdgcn_update_dpp(0, __builtin_bit_cast(int, v), CTRL, ROWMASK, 0xf, BOUND));
}
__device__ __forceinline__ float wave_prefix(float v) {
    v = dpp_add<0x111, 0xf, true>(v); v = dpp_add<0x112, 0xf, true>(v); v = dpp_add<0x114, 0xf, true>(v); v = dpp_add<0x118, 0xf, true>(v);
    v = dpp_add<0x142, 0xa, false>(v); v = dpp_add<0x143, 0xc, false>(v);
    return v;
}
__device__ __forceinline__ void wave_scan16(float (&gf)[8], float (&gb)[8], int lane) {
    (void)lane;
#pragma unroll
    for (int e = 0; e < 8; ++e) {
        gf[e] = wave_prefix(gf[e]);
        const float x = gb[e], pf = wave_prefix(x);
        const float tot = __builtin_bit_cast(float, __builtin_amdgcn_readlane(__builtin_bit_cast(int, pf), 63));
        gb[e] = (tot - pf) + x;
    }
}
__device__ __forceinline__ void lds_put_col8(LAS unsigned char* lds, int base, int row0, int col, const u32x4 w) {
    const unsigned ww[4] = {w.x, w.y, w.z, w.w};
#pragma unroll
    for (int e = 0; e < 8; ++e) *(LAS bf16_t*)(lds + base + ((row0 + e) * 72 + col) * 2) = (bf16_t)((e & 1) ? (ww[e >> 1] >> 16) : (ww[e >> 1] & 0xffffu));
}

struct M1Raw { u32x4 laf, lab, k, v0, v1; };
__device__ __forceinline__ void m1_load(const bf16_t* P, int item, int wid, int lane, M1Raw& r) {
    const int gc = item >> 2, h = item & 3, tid = wid * 64 + lane; const bf16_t* row = P + (size_t)(gc * 64 + (tid >> 3)) * NIN + (tid & 7) * 8;
    r.laf = *(const u32x4*)(row + PC_ZF + h * 64); r.lab = *(const u32x4*)(row + PC_ZB + h * 64); r.k = *(const u32x4*)(row + PC_K + h * 64);
    r.v0 = *(const u32x4*)(P + (size_t)(gc * 64 + (tid >> 4)) * NIN + PC_V + h * 128 + (tid & 15) * 8); r.v1 = *(const u32x4*)(P + (size_t)(gc * 64 + 32 + (tid >> 4)) * NIN + PC_V + h * 128 + (tid & 15) * 8);
}
__device__ __forceinline__ void m1_stage(LAS unsigned char* lds, int base, int tid, const M1Raw& r) {
    const int o = ((tid >> 3) * 72 + (tid & 7) * 8) * 2;
    *(LAS u32x4*)(lds + base + o) = r.laf; *(LAS u32x4*)(lds + base + 9216 + o) = r.lab; *(LAS u32x4*)(lds + base + 18432 + o) = r.k;
    *(LAS u32x4*)(lds + base + 27648 + ((tid >> 4) * 136 + (tid & 15) * 8) * 2) = r.v0; *(LAS u32x4*)(lds + base + 27648 + ((32 + (tid >> 4)) * 136 + (tid & 15) * 8) * 2) = r.v1;
}
__device__ void phase_m1(const Params& p, LAS unsigned char* lds) {
    int tid_l = threadIdx.x; asm volatile("" : "+v"(tid_l)); const int tid = tid_l, wid = tid >> 6, lane = tid & 63, fr = lane & 15, fq = lane >> 4;
    const bf16_t* P = (const bf16_t*)(p.ws + OFF_R1); bf16_t* KV = (bf16_t*)(p.ws + OFF_R3); float* DEC = (float*)(p.ws + OFF_DEC);
    constexpr int KTF = 0, KTB = 9216, VT = 18432, OUT = 36864, RAW = 73728;
    M1Raw R; int item = blockIdx.x;
    if (item < 4096) m1_load(P, item, wid, lane, R);
    for (; item < 4096; item += gridDim.x) {
        m1_stage(lds, RAW, tid, R);
        if (item + (int)gridDim.x < 4096) m1_load(P, item + gridDim.x, wid, lane, R);
        __syncthreads();
        {
            const int lo = (lane * 72 + wid * 8) * 2;
            float gf[8], gb[8], k[8]; unpack8(*(const LAS u32x4*)(lds + RAW + lo), gf); unpack8(*(const LAS u32x4*)(lds + RAW + 9216 + lo), gb); unpack8(*(const LAS u32x4*)(lds + RAW + 18432 + lo), k);
            const u32x4 rv0 = *(const LAS u32x4*)(lds + RAW + 27648 + (lane * 136 + wid * 8) * 2), rv1 = *(const LAS u32x4*)(lds + RAW + 27648 + (lane * 136 + 64 + wid * 8) * 2);
            float decf[8], decb[8]; unsigned kfp[4], kbp[4];
            wave_scan16(gf, gb, lane);
#pragma unroll
            for (int e = 0; e < 8; ++e) { decf[e] = __shfl(gf[e], 63); decb[e] = __shfl(gb[e], 0); }
#pragma unroll
            for (int e = 0; e < 8; ++e) { const float glf = decf[e], glb = decb[e];
                const float kf = k[e] * __builtin_amdgcn_exp2f(glf - gf[e]), kb = k[e] * __builtin_amdgcn_exp2f(glb - gb[e]);
                *(LAS bf16_t*)(lds + KTF + ((wid * 8 + e) * 72 + lane) * 2) = f2bf(kf); *(LAS bf16_t*)(lds + KTB + ((wid * 8 + e) * 72 + lane) * 2) = f2bf(kb);
                decf[e] = __builtin_amdgcn_exp2f(glf); decb[e] = __builtin_amdgcn_exp2f(glb); }
            (void)kfp; (void)kbp;
            if (lane == 0) { float* df = DEC + kv_idx(item >> 2, item & 3, 0) * 64 + wid * 8; float* db = DEC + kv_idx(item >> 2, item & 3, 1) * 64 + wid * 8;
                *(f32x4*)df = (f32x4){decf[0], decf[1], decf[2], decf[3]}; *(f32x4*)(df + 4) = (f32x4){decf[4], decf[5], decf[6], decf[7]};
                *(f32x4*)db = (f32x4){decb[0], decb[1], decb[2], decb[3]}; *(f32x4*)(db + 4) = (f32x4){decb[4], decb[5], decb[6], decb[7]}; }
            lds_put_col8(lds, VT, wid * 8, lane, rv0); lds_put_col8(lds, VT, 64 + wid * 8, lane, rv1);
        }
        __syncthreads();
        { const int dir = wid >> 2, dt = wid & 3;
            const int abase = (dir ? KTB : KTF) + ((dt * 16 + fr) * 72 + fq * 8) * 2;
            const bf16x8 a0 = lds_frag(lds, abase), a1 = lds_frag(lds, abase + 64);
#pragma unroll
            for (int vt = 0; vt < 8; ++vt) {
                const int bbase = VT + ((vt * 16 + fr) * 72 + fq * 8) * 2;
                f32x4 c = {0.f, 0.f, 0.f, 0.f};
                c = MFMA16(a0, lds_frag(lds, bbase), c); c = MFMA16(a1, lds_frag(lds, bbase + 64), c);
                u32x2 w; w.x = cvt_pk_bf16(c[0], c[1]); w.y = cvt_pk_bf16(c[2], c[3]);
                *(LAS u32x2*)(lds + OUT + dir * 18432 + ((vt * 16 + fr) * 72 + dt * 16 + fq * 4) * 2) = w;
            } }
        __syncthreads();
#pragma unroll
        for (int q = 0; q < 4; ++q) { const int vv = tid + q * 512, dir = vv >> 10, rem = vv & 1023, v = rem >> 3, d8 = (rem & 7) * 8;
            const u32x4 w = *(const LAS u32x4*)(lds + OUT + dir * 18432 + (v * 72 + d8) * 2);
            *(u32x4*)(KV + kv_idx(item >> 2, item & 3, dir) * 8192 + v * 64 + d8) = w; }
    }
}

template <int V, int NB> struct M2Buf { float kv[NB][V], dc[NB][V]; };
template <int V, int NB> __device__ __forceinline__ void m2_ld(M2Buf<V, NB>& B, const bf16_t* KV, const float* DEC, int gc0, int N, int h, int dir, int e, int s0) {
    const int d = e & 63;
#pragma unroll
    for (int b = 0; b < NB; ++b) {
        const int n = dir ? N - 1 - (s0 + b) : (s0 + b); const size_t idx = kv_idx(gc0 + n, h, dir);
        if (V == 4) { const u32x2 w = *(const u32x2*)(KV + idx * 8192 + e); const f32x4 c = *(const f32x4*)(DEC + idx * 64 + d);
            B.kv[b][0] = bflo(w.x); B.kv[b][1 % V] = bfhi(w.x); B.kv[b][2 % V] = bflo(w.y); B.kv[b][3 % V] = bfhi(w.y); B.dc[b][0] = c[0]; B.dc[b][1 % V] = c[1]; B.dc[b][2 % V] = c[2]; B.dc[b][3 % V] = c[3]; }
        else { B.kv[b][0] = bf2f(KV[idx * 8192 + e]); B.dc[b][0] = DEC[idx * 64 + d]; }
    }
}
template <int V, int NB> __device__ __forceinline__ void m2_st(const M2Buf<V, NB>& B, float (&st)[V], bf16_t* KV, int gc0, int N, int h, int dir, int e, int s0) {
#pragma unroll
    for (int b = 0; b < NB; ++b) {
        const int n = dir ? N - 1 - (s0 + b) : (s0 + b); const size_t idx = kv_idx(gc0 + n, h, dir);
        if (V == 4) { u32x2 o; o.x = cvt_pk_bf16(st[0], st[1 % V]); o.y = cvt_pk_bf16(st[2 % V], st[3 % V]); *(u32x2*)(KV + idx * 8192 + e) = o; }
        else { KV[idx * 8192 + e] = f2bf(st[0]); }
#pragma unroll
        for (int i = 0; i < V; ++i) st[i] = B.dc[b][i] * st[i] + B.kv[b][i];
    }
}
template <int V, int NB> __device__ __forceinline__ void m2_chain(bf16_t* KV, const float* DEC, int gc0, int N, int h, int dir, int e) {
    float st[V];
#pragma unroll
    for (int i = 0; i < V; ++i) st[i] = 0.f;
    M2Buf<V, NB> A, B;
    m2_ld<V, NB>(A, KV, DEC, gc0, N, h, dir, e, 0);
    for (int s0 = 0; s0 < N; s0 += 2 * NB) {
        m2_ld<V, NB>(B, KV, DEC, gc0, N, h, dir, e, s0 + NB);
        m2_st<V, NB>(A, st, KV, gc0, N, h, dir, e, s0);
        if (s0 + 2 * NB < N) m2_ld<V, NB>(A, KV, DEC, gc0, N, h, dir, e, s0 + 2 * NB);
        m2_st<V, NB>(B, st, KV, gc0, N, h, dir, e, s0 + NB);
    }
}
__device__ void phase_m2(const Params& p) {
    int tid_l = threadIdx.x; asm volatile("" : "+v"(tid_l)); const int tid = tid_l;
    bf16_t* KV = (bf16_t*)(p.ws + OFF_R3); const float* DEC = (const float*)(p.ws + OFF_DEC);
    for (int it = blockIdx.x; it < 256; it += gridDim.x) {
        const int sc = 128 + (it >> 4), slab = it & 15;
        const int s = sc >> 3, h = (sc >> 1) & 3, dir = sc & 1;
        m2_chain<1, 16>(KV, DEC, 512 + (s - 16) * 256, 256, h, dir, slab * 512 + tid);
    }
    for (int it = blockIdx.x; it < 512; it += gridDim.x) {
        const int sc = it >> 2, slab = it & 3;
        const int s = sc >> 3, h = (sc >> 1) & 3, dir = sc & 1;
        m2_chain<4, 8>(KV, DEC, s * 32, 32, h, dir, slab * 2048 + tid * 4);
    }
}

struct M3Raw { u32x4 laf, lab, q, k, v0, v1, g0, g1, pt[4]; };
__device__ __forceinline__ void m3_load(const bf16_t* P, const bf16_t* KV, int gc, int h, int tid, M3Raw& r) {
    const bf16_t* row = P + (size_t)(gc * 64 + (tid >> 3)) * NIN + (tid & 7) * 8;
    r.laf = *(const u32x4*)(row + PC_ZF + h * 64); r.lab = *(const u32x4*)(row + PC_ZB + h * 64); r.q = *(const u32x4*)(row + PC_Q + h * 64); r.k = *(const u32x4*)(row + PC_K + h * 64);
    r.v0 = *(const u32x4*)(P + (size_t)(gc * 64 + (tid >> 4)) * NIN + PC_V + h * 128 + (tid & 15) * 8); r.v1 = *(const u32x4*)(P + (size_t)(gc * 64 + 32 + (tid >> 4)) * NIN + PC_V + h * 128 + (tid & 15) * 8);
    r.g0 = *(const u32x4*)(P + (size_t)(gc * 64 + (tid >> 4)) * NIN + PC_G + h * 128 + (tid & 15) * 8); r.g1 = *(const u32x4*)(P + (size_t)(gc * 64 + 32 + (tid >> 4)) * NIN + PC_G + h * 128 + (tid & 15) * 8);
#pragma unroll
    for (int qi = 0; qi < 4; ++qi) r.pt[qi] = *(const u32x4*)(KV + kv_idx(gc, h, qi >> 1) * 8192 + (size_t)(tid + (qi & 1) * 512) * 8);
}
__device__ void m3_gla_all(const Params& p, int l, LAS unsigned char* lds) {
    int tid_l = threadIdx.x; asm volatile("" : "+v"(tid_l)); const int tid = tid_l, wid = tid >> 6, lane = tid & 63, fr = lane & 15, fq = lane >> 4;
    const bf16_t* P = (const bf16_t*)(p.ws + OFF_R1); const bf16_t* KV = (const bf16_t*)(p.ws + OFF_R3); bf16_t* MIX = (bf16_t*)(p.ws + OFF_R2);
    constexpr int QF = 0, QB = 9216, KF = 18432, KB = 27648, VT = 36864, PTF = 55296, PTB = 73728, AT = 92160, RS = 101376, RAW = 101888;
    LAS float* RSS = (LAS float*)(lds + RS);
    const int G = gridDim.x, nit = (2048 - (int)blockIdx.x + G - 1) / G * 2;
    M3Raw R;
    if (nit > 0) m3_load(P, KV, ((int)blockIdx.x >> 2) * 2, (int)blockIdx.x & 3, tid, R);
    for (int kk = 0; kk < nit; ++kk) {
        const int item = blockIdx.x + (kk >> 1) * G, cc = kk & 1, h = item & 3, gc = (item >> 2) * 2 + cc, t0 = gc * 64;
        const float* ng = p.gla_norm_g + l * 512 + h * 128;
        { const int o = ((tid >> 3) * 72 + (tid & 7) * 8) * 2;
            *(LAS u32x4*)(lds + RAW + o) = R.laf; *(LAS u32x4*)(lds + RAW + 9216 + o) = R.lab; *(LAS u32x4*)(lds + RAW + 18432 + o) = R.q; *(LAS u32x4*)(lds + RAW + 27648 + o) = R.k;
            *(LAS u32x4*)(lds + RAW + 36864 + ((tid >> 4) * 136 + (tid & 15) * 8) * 2) = R.v0; *(LAS u32x4*)(lds + RAW + 36864 + ((32 + (tid >> 4)) * 136 + (tid & 15) * 8) * 2) = R.v1;
#pragma unroll
            for (int qi = 0; qi < 4; ++qi) { const int vv = tid + (qi & 1) * 512, v = vv >> 3, d8 = (vv & 7) * 8; *(LAS u32x4*)(lds + ((qi >> 1) ? PTB : PTF) + (v * 72 + d8) * 2) = R.pt[qi]; } }
        const u32x4 gcur0 = R.g0, gcur1 = R.g1;
        if (kk + 1 < nit) { const int itn = blockIdx.x + ((kk + 1) >> 1) * G; m3_load(P, KV, (itn >> 2) * 2 + ((kk + 1) & 1), itn & 3, tid, R); }
        __syncthreads();
        {
            const int lo = (lane * 72 + wid * 8) * 2;
            float gf[8], gb[8], q[8], k[8]; unpack8(*(const LAS u32x4*)(lds + RAW + lo), gf); unpack8(*(const LAS u32x4*)(lds + RAW + 9216 + lo), gb); unpack8(*(const LAS u32x4*)(lds + RAW + 18432 + lo), q); unpack8(*(const LAS u32x4*)(lds + RAW + 27648 + lo), k);
            const u32x4 rv0 = *(const LAS u32x4*)(lds + RAW + 36864 + (lane * 136 + wid * 8) * 2), rv1 = *(const LAS u32x4*)(lds + RAW + 36864 + (lane * 136 + 64 + wid * 8) * 2);
            wave_scan16(gf, gb, lane);
            float qf[8], qb[8], kf[8], kb[8];
#pragma unroll
            for (int e = 0; e < 8; ++e) { const float qs = q[e] * 0.125f; qf[e] = qs * __builtin_amdgcn_exp2f(gf[e]); qb[e] = qs * __builtin_amdgcn_exp2f(gb[e]); kf[e] = k[e] * __builtin_amdgcn_exp2f(-gf[e]); kb[e] = k[e] * __builtin_amdgcn_exp2f(-gb[e]); }
            const int o = (lane * 72 + wid * 8) * 2;
            u32x4 w;
            w.x = cvt_pk_bf16(qf[0], qf[1]); w.y = cvt_pk_bf16(qf[2], qf[3]); w.z = cvt_pk_bf16(qf[4], qf[5]); w.w = cvt_pk_bf16(qf[6], qf[7]); *(LAS u32x4*)(lds + QF + o) = w;
            w.x = cvt_pk_bf16(qb[0], qb[1]); w.y = cvt_pk_bf16(qb[2], qb[3]); w.z = cvt_pk_bf16(qb[4], qb[5]); w.w = cvt_pk_bf16(qb[6], qb[7]); *(LAS u32x4*)(lds + QB + o) = w;
            w.x = cvt_pk_bf16(kf[0], kf[1]); w.y = cvt_pk_bf16(kf[2], kf[3]); w.z = cvt_pk_bf16(kf[4], kf[5]); w.w = cvt_pk_bf16(kf[6], kf[7]); *(LAS u32x4*)(lds + KF + o) = w;
            w.x = cvt_pk_bf16(kb[0], kb[1]); w.y = cvt_pk_bf16(kb[2], kb[3]); w.z = cvt_pk_bf16(kb[4], kb[5]); w.w = cvt_pk_bf16(kb[6], kb[7]); *(LAS u32x4*)(lds + KB + o) = w;
            lds_put_col8(lds, VT, wid * 8, lane, rv0); lds_put_col8(lds, VT, 64 + wid * 8, lane, rv1);
        }
        const int itl = wid >> 1, vh = wid & 1;
        __syncthreads();
        *(LAS u32x4*)(lds + RAW + ((tid >> 4) * 136 + (tid & 15) * 8) * 2) = gcur0; *(LAS u32x4*)(lds + RAW + ((32 + (tid >> 4)) * 136 + (tid & 15) * 8) * 2) = gcur1;
#pragma unroll
        for (int tt = 0; tt < 2; ++tt) {
            const int tile = wid * 2 + tt, ti = tile >> 2, jt = tile & 3;
            f32x4 cf = {0.f, 0.f, 0.f, 0.f}, cb = {0.f, 0.f, 0.f, 0.f};
            const int ao = ((ti * 16 + fr) * 72 + fq * 8) * 2, bo = ((jt * 16 + fr) * 72 + fq * 8) * 2;
            if (jt <= ti) { cf = MFMA16(lds_frag(lds, QF + ao), lds_frag(lds, KF + bo), cf); cf = MFMA16(lds_frag(lds, QF + ao + 64), lds_frag(lds, KF + bo + 64), cf); }
            if (jt >= ti) { cb = MFMA16(lds_frag(lds, QB + ao), lds_frag(lds, KB + bo), cb); cb = MFMA16(lds_frag(lds, QB + ao + 64), lds_frag(lds, KB + bo + 64), cb); }
            const int j = jt * 16 + fr;
#pragma unroll
            for (int r = 0; r < 4; ++r) { const int i = ti * 16 + fq * 4 + r;
                const float v = (j <= i ? cf[r] : 0.f) + (j >= i ? cb[r] : 0.f);
                *(LAS bf16_t*)(lds + AT + (i * 72 + j) * 2) = f2bf(v); }
        }
        __syncthreads();
        {
            const int ao = ((itl * 16 + fr) * 72 + fq * 8) * 2;
            const bf16x8 aA0 = lds_frag(lds, AT + ao), aA1 = lds_frag(lds, AT + ao + 64), aF0 = lds_frag(lds, QF + ao), aF1 = lds_frag(lds, QF + ao + 64), aB0 = lds_frag(lds, QB + ao), aB1 = lds_frag(lds, QB + ao + 64);
            f32x4 o[4]; float sq = 0.f;
#pragma unroll
            for (int q = 0; q < 4; ++q) {
                const int vt = vh * 4 + q, bo = ((vt * 16 + fr) * 72 + fq * 8) * 2;
                f32x4 c = {0.f, 0.f, 0.f, 0.f};
                c = MFMA16(lds_frag(lds, VT + bo), aA0, c); c = MFMA16(lds_frag(lds, VT + bo + 64), aA1, c);
                c = MFMA16(lds_frag(lds, PTF + bo), aF0, c); c = MFMA16(lds_frag(lds, PTF + bo + 64), aF1, c);
                c = MFMA16(lds_frag(lds, PTB + bo), aB0, c); c = MFMA16(lds_frag(lds, PTB + bo + 64), aB1, c);
                o[q] = c; sq += (c[0] * c[0] + c[1] * c[1]) + (c[2] * c[2] + c[3] * c[3]);
            }
            sq += __shfl_xor(sq, 16); sq += __shfl_xor(sq, 32);
            if (fq == 0) RSS[(itl * 16 + fr) * 2 + vh] = sq;
            __syncthreads();
            const int i = itl * 16 + fr; const float rs = rsqrtf((RSS[i * 2] + RSS[i * 2 + 1]) * (1.0f / 128.0f) + EPSF);
#pragma unroll
            for (int q = 0; q < 4; ++q) {
                const int v4 = (vh * 4 + q) * 16 + fq * 4;
                const f32x4 gn = *(const f32x4*)(ng + v4);
                const u32x2 gw = *(const LAS u32x2*)(lds + RAW + (i * 136 + v4) * 2);
                const float g0 = bflo(gw.x), g1 = bfhi(gw.x), g2 = bflo(gw.y), g3 = bfhi(gw.y);
                u32x2 w; w.x = cvt_pk_bf16(o[q][0] * rs * gn[0] * siluf_(g0), o[q][1] * rs * gn[1] * siluf_(g1)); w.y = cvt_pk_bf16(o[q][2] * rs * gn[2] * siluf_(g2), o[q][3] * rs * gn[3] * siluf_(g3));
                *(LAS u32x2*)(lds + VT + (i * 136 + v4) * 2) = w;
            }
        }
        __syncthreads();
#pragma unroll
        for (int q = 0; q < 2; ++q) { const int vv = tid + q * 512, i = vv >> 4, c8 = (vv & 15) * 8;
            *(u32x4*)(MIX + (size_t)(t0 + i) * DM + h * 128 + c8) = *(const LAS u32x4*)(lds + VT + (i * 136 + c8) * 2); }
    }
}

__device__ void m3_sgu(const Params& p, int l, int tb, LAS unsigned char* lds) {
    int tid_l = threadIdx.x; asm volatile("" : "+v"(tid_l)); const int tid = tid_l, wid = tid >> 6, lane = tid & 63, fr = lane & 15, fq = lane >> 4;
    const bf16_t* P = (const bf16_t*)(p.ws + OFF_R1); bf16_t* MIX = (bf16_t*)(p.ws + OFF_R2);
    constexpr int VT = 0, WS = 256 * 136 * 2, PART = WS + 128 * 136 * 2, RAWS = PART + 4096;
    const int tbase = tb * 128;
    f32x4 wreg[8];
    { const float* wsrc = p.sgu_w + ((size_t)(l * 4) * 128) * 128;
#pragma unroll
        for (int q = 0; q < 8; ++q) wreg[q] = *(const f32x4*)(wsrc + (size_t)(tid + q * 512) * 4); }
    u32x4 xin[2][4];
#pragma unroll
    for (int hf = 0; hf < 2; ++hf)
#pragma unroll
        for (int q = 0; q < 4; ++q) { const int vv = tid + q * 512; xin[hf][q] = *(const u32x4*)(P + (size_t)(tbase + hf * 64 + (vv >> 5)) * NIN + PC_VS + (vv & 31) * 8); }
#pragma unroll
    for (int hf = 0; hf < 2; ++hf) {
#pragma unroll
        for (int q = 0; q < 4; ++q) { const int vv = tid + q * 512; *(LAS u32x4*)(lds + RAWS + ((vv >> 5) * 264 + (vv & 31) * 8) * 2) = xin[hf][q]; }
        __syncthreads();
        const int s = tid & 63, cg = tid >> 6;
        u32x4 xr[4];
#pragma unroll
        for (int q = 0; q < 4; ++q) xr[q] = *(const LAS u32x4*)(lds + RAWS + (s * 264 + cg * 32 + q * 8) * 2);
        float sm = 0.f, sq = 0.f;
#pragma unroll
        for (int q = 0; q < 4; ++q) { float x[8]; unpack8(xr[q], x);
#pragma unroll
            for (int e = 0; e < 8; ++e) { sm += x[e]; sq += x[e] * x[e]; } }
        *(LAS f32x2v*)(lds + PART + (cg * 64 + s) * 8) = (f32x2v){sm, sq};
        __syncthreads();
        float tsm = 0.f, tsq = 0.f;
#pragma unroll
        for (int g = 0; g < 8; ++g) { const f32x2v t = *(const LAS f32x2v*)(lds + PART + (g * 64 + s) * 8); tsm += t.x; tsq += t.y; }
        const float mu = tsm * (1.0f / 256.0f), rstd = rsqrtf(fmaxf(tsq * (1.0f / 256.0f) - mu * mu, 0.f) + EPSF);
        const float* lg = p.sgu_ln_g + l * 256 + cg * 32; const float* lb = p.sgu_ln_b + l * 256 + cg * 32;
#pragma unroll
        for (int q = 0; q < 4; ++q) { float x[8]; unpack8(xr[q], x);
            const f32x4 g0 = *(const f32x4*)(lg + q * 8), g1 = *(const f32x4*)(lg + q * 8 + 4), b0 = *(const f32x4*)(lb + q * 8), b1 = *(const f32x4*)(lb + q * 8 + 4);
            LAS unsigned char* wp = lds + VT + ((cg * 32 + q * 8) * 136 + hf * 64 + s) * 2;
#pragma unroll
            for (int e = 0; e < 8; ++e) { const float y = (x[e] - mu) * rstd * (e < 4 ? g0[e & 3] : g1[e & 3]) + (e < 4 ? b0[e & 3] : b1[e & 3]);
                *(LAS bf16_t*)(wp + e * 272) = f2bf(y); } }
    }
    for (int h = 0; h < 4; ++h) {
#pragma unroll
        for (int q = 0; q < 8; ++q) { const int vv = tid + q * 512, t = vv >> 5, s4 = (vv & 31) * 4;
            u32x2 w; w.x = cvt_pk_bf16(wreg[q][0], wreg[q][1]); w.y = cvt_pk_bf16(wreg[q][2], wreg[q][3]);
            *(LAS u32x2*)(lds + WS + (t * 136 + s4) * 2) = w; }
        const int t = tbase + wid * 16 + fr;
        u32x2 uw[4];
#pragma unroll
        for (int ct = 0; ct < 4; ++ct) uw[ct] = *(const u32x2*)(P + (size_t)t * NIN + PC_U + h * 64 + ct * 16 + fq * 4);
        const float bs = p.sgu_b[(l * 4 + h) * 128 + wid * 16 + fr];
        if (h < 3) { const float* wsrc = p.sgu_w + ((size_t)(l * 4 + h + 1) * 128) * 128;
#pragma unroll
            for (int q = 0; q < 8; ++q) wreg[q] = *(const f32x4*)(wsrc + (size_t)(tid + q * 512) * 4); }
        __syncthreads();
        {
            const int ao = WS + ((wid * 16 + fr) * 136 + fq * 8) * 2;
            bf16x8 a[4];
#pragma unroll
            for (int ks = 0; ks < 4; ++ks) a[ks] = lds_frag(lds, ao + ks * 64);
#pragma unroll
            for (int ct = 0; ct < 4; ++ct) {
                const int bo = VT + ((h * 64 + ct * 16 + fr) * 136 + fq * 8) * 2;
                f32x4 c = {0.f, 0.f, 0.f, 0.f};
#pragma unroll
                for (int ks = 0; ks < 4; ++ks) c = MFMA16(lds_frag(lds, bo + ks * 64), a[ks], c);
                const int c4 = h * 64 + ct * 16 + fq * 4;
                u32x2 w; w.x = cvt_pk_bf16((c[0] + bs) * bflo(uw[ct].x), (c[1] + bs) * bfhi(uw[ct].x)); w.y = cvt_pk_bf16((c[2] + bs) * bflo(uw[ct].y), (c[3] + bs) * bfhi(uw[ct].y));
                *(u32x2*)(MIX + (size_t)t * DM + 512 + c4) = w;
            }
        }
        __syncthreads();
    }
}

__device__ void m3_pool(const Params& p, int l, int tb, LAS unsigned char* lds) {
    int tid_l = threadIdx.x; asm volatile("" : "+v"(tid_l)); const int tid = tid_l, wid = tid >> 6, lane = tid & 63, fr = lane & 15, fq = lane >> 4;
    const bf16_t* P = (const bf16_t*)(p.ws + OFF_R1); bf16_t* MIX = (bf16_t*)(p.ws + OFF_R2);
    constexpr int XO = 0, DD = 144 * 256 * 2, PW = 0;
    const int tbase = tb * 128; int s0, S; seq_of(tbase, s0, S); const int s1 = s0 + S;
    f32x4 pw[8];
#pragma unroll
    for (int q = 0; q < 8; ++q) pw[q] = *(const f32x4*)(p.pool_w + (size_t)l * 16384 + (size_t)(tid + q * 512) * 4);
#pragma unroll 3
    for (int q = 0; q < 9; ++q) { const int vv = tid + q * 512, rl = vv >> 5, c8 = (vv & 31) * 8; const int t = tbase - 8 + rl;
        u32x4 w = {0u, 0u, 0u, 0u};
        if (t >= s0 && t < s1) w = *(const u32x4*)(P + (size_t)t * NIN + PC_XP + c8);
        *(LAS u32x4*)(lds + XO + (rl * 256 + c8) * 2) = w; }
    __syncthreads();
    {
        const int c = tid & 63, gi = (tid >> 6) & 3, half = tid >> 8, hh = 1 << gi, col = gi * 64 + c;
        const int tA = tbase + half * 64;
        LAS unsigned char* xc = lds + XO + col * 2 - (tbase - 8) * 512;
        int lo = tA - hh; if (lo < s0) lo = s0; int hi = tA + hh; if (hi > s1) hi = s1;
        float sum = 0.f;
        for (int r = lo; r < hi; ++r) sum += bf2f(*(LAS bf16_t*)(xc + r * 512));
#pragma unroll 4
        for (int t = tA; t < tA + 64; ++t) {
            const float x = bf2f(*(LAS bf16_t*)(xc + t * 512));
            const float dv = sum * __builtin_amdgcn_rcpf((float)(hi - lo)) - x;
            *(LAS bf16_t*)(lds + DD + ((t - tbase) * 264 + col) * 2) = f2bf(dv);
            int nlo = t + 1 - hh; if (nlo < s0) nlo = s0; int nhi = t + 1 + hh; if (nhi > s1) nhi = s1;
            if (nhi > hi) sum += bf2f(*(LAS bf16_t*)(xc + hi * 512));
            if (nlo > lo) sum -= bf2f(*(LAS bf16_t*)(xc + lo * 512));
            lo = nlo; hi = nhi;
        }
    }
    __syncthreads();
#pragma unroll
    for (int q = 0; q < 8; ++q) { const int el = (tid + q * 512) * 4, g = el >> 12, c = (el >> 6) & 63, dd4 = el & 63;
#pragma unroll
        for (int i = 0; i < 4; ++i) *(LAS bf16_t*)(lds + PW + g * 9216 + ((dd4 + i) * 72 + c) * 2) = f2bf(pw[q][i]); }
    __syncthreads();
    {
        const int t = tbase + wid * 16 + fr;
#pragma unroll
        for (int gi = 0; gi < 4; ++gi) {
            const int ao = DD + ((wid * 16 + fr) * 264 + gi * 64 + fq * 8) * 2;
            const bf16x8 a0 = lds_frag(lds, ao), a1 = lds_frag(lds, ao + 64);
#pragma unroll
            for (int dt = 0; dt < 4; ++dt) {
                const int bo = PW + gi * 9216 + ((dt * 16 + fr) * 72 + fq * 8) * 2;
                f32x4 c = {0.f, 0.f, 0.f, 0.f};
                c = MFMA16(lds_frag(lds, bo), a0, c); c = MFMA16(lds_frag(lds, bo + 64), a1, c);
                const int d4 = gi * 64 + dt * 16 + fq * 4;
                const f32x4 sc = *(const f32x4*)(p.pool_scale + l * 256 + d4);
                u32x2 w; w.x = cvt_pk_bf16(c[0] * sc[0], c[1] * sc[1]); w.y = cvt_pk_bf16(c[2] * sc[2], c[3] * sc[3]);
                *(u32x2*)(MIX + (size_t)t * DM + 768 + d4) = w;
            }
        }
    }
    __syncthreads();
}

__device__ void phase_m3(const Params& p, int l, LAS unsigned char* lds) {
    m3_gla_all(p, l, lds);
#pragma nounroll
    for (int item = blockIdx.x; item < 512; item += gridDim.x) { m3_sgu(p, l, item, lds); }
#pragma nounroll
    for (int item = blockIdx.x; item < 512; item += gridDim.x) { m3_pool(p, l, item, lds); }
}

template <class Sched> __device__ __forceinline__ void fix_panels(const Params& p, int l, const Sched& S) {
    bf16_t* ACT = (bf16_t*)(p.ws + OFF_R1); const float* side = (const float*)(p.ws + OFF_R2);
    const float* cw = p.conv_w + (size_t)l * 3 * DFF;
    int tid_l = threadIdx.x; asm volatile("" : "+v"(tid_l)); const int tid = tid_l;
    Unit u;
    for (int ui = 0; S.next(ui, u); ++ui) {
#pragma unroll 4
        for (int i = tid; i < 8 * (DFF / 4); i += 512) {
            const int c4 = (i % (DFF / 4)) * 4, rb = i / (DFF / 4), blk = u.pm * 4 + (rb >> 1), last = rb & 1;
            const int row = blk * 64 + (last ? 63 : 0);
            int s0, Sq; seq_of(row, s0, Sq);
            const float* sb = side + (size_t)blk * 6 * DFF + (last ? 3 * DFF : 0) + c4;
            f32x4 z = *(const f32x4*)sb; const f32x4 up = *(const f32x4*)(sb + DFF);
            if (!last && row != s0) { const f32x4 an = *(const f32x4*)(side + (size_t)(blk - 1) * 6 * DFF + 5 * DFF + c4), w = *(const f32x4*)(cw + c4); z += w * an; }
            if (last && row != s0 + Sq - 1) { const f32x4 an = *(const f32x4*)(side + (size_t)(blk + 1) * 6 * DFF + 2 * DFF + c4), w = *(const f32x4*)(cw + 2 * DFF + c4); z += w * an; }
            u32x2 o; o.x = cvt_pk_bf16(siluf_(z[0]) * up[0], siluf_(z[1]) * up[1]); o.y = cvt_pk_bf16(siluf_(z[2]) * up[2], siluf_(z[3]) * up[3]);
            *(u32x2*)(ACT + (size_t)row * DFF + c4) = o;
        }
    }
    asm volatile("s_waitcnt vmcnt(0)" ::: "memory");
    __syncthreads();
}

__device__ void phase_final(const Params& p) {
    const float* SS1 = (const float*)(p.ws + OFF_SS1); const bf16_t* X = (const bf16_t*)(p.ws + OFF_R2);
    int tid_l = threadIdx.x; asm volatile("" : "+v"(tid_l)); const int tid = tid_l, wid = tid >> 6, lane = tid & 63;
    f32x4 g[4];
#pragma unroll
    for (int h = 0; h < 2; ++h) { g[2 * h] = *(const f32x4*)(p.norm_f + h * 512 + lane * 8); g[2 * h + 1] = *(const f32x4*)(p.norm_f + h * 512 + lane * 8 + 4); }
    for (int row0 = (blockIdx.x * 8 + wid) * 4; row0 < T_TOK; row0 += gridDim.x * 32) {
        u32x4 w[4][2]; float rs[4];
#pragma unroll
        for (int r = 0; r < 4; ++r) { rs[r] = sum16(SS1 + (size_t)(row0 + r) * 16); w[r][0] = *(const u32x4*)(X + (size_t)(row0 + r) * DM + lane * 8); w[r][1] = *(const u32x4*)(X + (size_t)(row0 + r) * DM + 512 + lane * 8); }
#pragma unroll
        for (int r = 0; r < 4; ++r) {
            const float sc = rsqrtf(rs[r] * (1.0f / 1024.0f) + EPSF);
            float* xr = p.out + (size_t)(row0 + r) * DM;
#pragma unroll
            for (int h = 0; h < 2; ++h) { float x[8]; unpack8(w[r][h], x);
                __builtin_nontemporal_store((f32x4){x[0], x[1], x[2], x[3]} * sc * g[2 * h], (f32x4*)(xr + h * 512 + lane * 8)); __builtin_nontemporal_store((f32x4){x[4], x[5], x[6], x[7]} * sc * g[2 * h + 1], (f32x4*)(xr + h * 512 + lane * 8 + 4)); }
        }
    }
}

#define XB_TMO      128
#define XB_XCNT(j)  (256  + 64 * (j))
#define XB_XSUB(j)  (1280 + 64 * (j))
#define XB_XGEN(j)  (2304 + 64 * (j))
#define XB_TOP      3328
#define XB_TOPGEN   3392
#define XCD_BAR_WORDS 3456
#define XB_SPIN_CAP (1u << 18)
__device__ __forceinline__ unsigned xb_ld(unsigned* p)              { return __hip_atomic_load(p, __ATOMIC_RELAXED, __HIP_MEMORY_SCOPE_AGENT); }
__device__ __forceinline__ unsigned xb_add(unsigned* p, unsigned v) { return __hip_atomic_fetch_add(p, v, __ATOMIC_RELAXED, __HIP_MEMORY_SCOPE_AGENT); }
__device__ __forceinline__ unsigned xb_xcc_id() { return (unsigned)__builtin_amdgcn_s_getreg((3 << 11) | 20) & 0xFu; }
#define XB_SPIN(cond, bar) do { unsigned _sp = 0; while (cond) { __builtin_amdgcn_s_sleep(1); \
    if ((++_sp & 255u) == 0u) { if (xb_ld(&(bar)[XB_TMO])) break; if (_sp > XB_SPIN_CAP) { atomicAdd(&(bar)[XB_TMO], 1u); break; } } } } while (0)

struct XcdBarrier {
    unsigned* bar; unsigned x;
    volatile LAS unsigned* st;
};

__device__ __forceinline__ XcdBarrier xcd_barrier_post(unsigned* bar, volatile LAS unsigned* st) {
    XcdBarrier b; b.bar = bar; b.x = xb_xcc_id(); b.st = st;
    if (threadIdx.x == 0) (void)xb_add(&bar[XB_XCNT(b.x)], 1u);
    return b;
}
__device__ __forceinline__ void xcd_barrier_complete(unsigned* bar, unsigned x, unsigned& nloc, unsigned& nx) {
    const unsigned G = gridDim.x * gridDim.y * gridDim.z;
    unsigned sum, cnt, mine, sp = 0u;
    for (;;) {
        sum = 0u; cnt = 0u; mine = 0u;
#pragma unroll
        for (unsigned j = 0; j < 16; ++j) { const unsigned c = xb_ld(&bar[XB_XCNT(j)]); sum += c; cnt += (c > 0u) ? 1u : 0u; mine = (j == x) ? c : mine; }
        if (sum == G) break;
        __builtin_amdgcn_s_sleep(1);
        if ((++sp & 255u) == 0u) { if (xb_ld(&bar[XB_TMO])) break; if (sp > XB_SPIN_CAP) { atomicAdd(&bar[XB_TMO], 1u); break; } }
    }
    nloc = mine > 0u ? mine : 1u; nx = cnt > 0u ? cnt : 1u;
}

__device__ __forceinline__ void xcd_barrier(const XcdBarrier& b) {
    asm volatile("s_waitcnt vmcnt(0)" ::: "memory");
    __syncthreads();
    if (threadIdx.x == 0) {
        unsigned* bar = b.bar;
        __builtin_amdgcn_s_waitcnt(0);
        unsigned nloc = b.st[0], nx = b.st[1];
        if (nloc == 0u) { xcd_barrier_complete(bar, b.x, nloc, nx); b.st[0] = nloc; b.st[1] = nx; }
        const unsigned old = xb_add(&bar[XB_XSUB(b.x)], 1u);
        const unsigned gen = old / nloc;
        if (old + 1u == (gen + 1u) * nloc) {
            __builtin_amdgcn_fence(__ATOMIC_RELEASE, "agent");
            asm volatile("s_waitcnt vmcnt(0)" ::: "memory");
            const unsigned og = xb_add(&bar[XB_TOP], 1u);
            const unsigned tg = og / nx;
            if (og + 1u == (tg + 1u) * nx) xb_add(&bar[XB_TOPGEN], 1u);
            else XB_SPIN(xb_ld(&bar[XB_TOPGEN]) == tg, bar);
            __builtin_amdgcn_fence(__ATOMIC_ACQUIRE, "agent");
            xb_add(&bar[XB_XGEN(b.x)], 1u);
            asm volatile("s_waitcnt vmcnt(0)" ::: "memory");
        } else {
            XB_SPIN(xb_ld(&bar[XB_XGEN(b.x)]) == gen, bar);
            __builtin_amdgcn_fence(__ATOMIC_ACQUIRE, "agent");
            asm volatile("s_waitcnt vmcnt(0)" ::: "memory");
        }
    }
    __syncthreads();
}

#ifndef MK_SYNC
#define MK_SYNC() xcd_barrier(xb)
#define MK_SYNC_CG() do { asm volatile("s_waitcnt vmcnt(0)" ::: "memory"); grid.sync(); } while (0)
#endif
__global__ void __launch_bounds__(512, 2) fwd_megakernel(Params p) {
    extern __shared__ __attribute__((aligned(16))) unsigned char shm[];
    LAS unsigned char* lds = (LAS unsigned char*)shm;
    cg::grid_group grid = cg::this_grid();
    bf16_t* WB = (bf16_t*)(p.ws + OFF_WB);
    bf16_t* R1 = (bf16_t*)(p.ws + OFF_R1); bf16_t* R2 = (bf16_t*)(p.ws + OFF_R2); bf16_t* R3 = (bf16_t*)(p.ws + OFF_R3);
    float* SS1 = (float*)(p.ws + OFF_SS1); float* SS2 = (float*)(p.ws + OFF_SS2); bf16_t* XBUF = (bf16_t*)p.out;
    StaticOrder S;
    volatile LAS unsigned* xst = (volatile LAS unsigned*)(lds + 163840 - 16);
    if (threadIdx.x < 2) xst[threadIdx.x] = 0u;
    __syncthreads();
    const XcdBarrier xb = xcd_barrier_post((unsigned*)(p.ws + OFF_BAR), xst);
    phase_prep(p, lds);
    MK_SYNC();
    if (p.ws == nullptr) MK_SYNC_CG();
    for (int l = 0; l < NLAYER; ++l) {
        const bf16_t* wl = WB + (size_t)l * WB_LAYER;
        { StaticOrder S1, S2; S.init(T_TOK, 1792, (int)gridDim.x, (int)blockIdx.x); S1.init(T_TOK, 512, (int)gridDim.x, (int)blockIdx.x); S2 = S1;
            precompute_rs(lds, S, SS1, 0, false); precompute_rs(lds, S1, SS1, 7, true);
            { Gemm g{XBUF, wl + WB_IN, T_TOK, 1792, DM};
                EpiIn<0> E{R1, nullptr, 0, 0};
                gemm_phase<EpiIn<0>, StaticOrder, false>(lds, g, S, E, nullptr); }
            { Gemm g{XBUF, wl + WB_IN + (size_t)1792 * DM, T_TOK, 512, DM};
                EpiIn<1> E{R1, nullptr, 1792, 7};
                gemm_phase<EpiIn<1>, StaticOrder, false>(lds, g, S1, E, nullptr); }
            { Gemm g{XBUF, wl + WB_IN + (size_t)2304 * DM, T_TOK, 512, DM};
                EpiIn<2> E{R1, p.gate_b + l * 512, 2304, 7};
                gemm_phase<EpiIn<2>, StaticOrder, false>(lds, g, S2, E, nullptr); } }
        MK_SYNC();
        phase_m1(p, lds);
        MK_SYNC();
        phase_m2(p);
        MK_SYNC();
        phase_m3(p, l, lds);
        MK_SYNC();
        { Gemm g{R2, wl + WB_O, T_TOK, DM, DM}; S.init(g.M, g.N, (int)gridDim.x, (int)blockIdx.x);
            EpiRes E{XBUF, R3, SS2};
            gemm_phase<EpiRes, StaticOrder, false>(lds, g, S, E, nullptr); }
        MK_SYNC();
        { Gemm g{R3, wl + WB_1, T_TOK, 2 * DFF, DM}; S.init(g.M, g.N, (int)gridDim.x, (int)blockIdx.x);
            EpiFfn E{R1, SS2, p.conv_w + (size_t)l * 3 * DFF, p.conv_b + (size_t)l * DFF, (float*)R2};
            precompute_rs(lds, S, SS2);
            gemm_phase<EpiFfn, StaticOrder, false>(lds, g, S, E, nullptr); }
        MK_SYNC();
        { Gemm g{R1, wl + WB_2, T_TOK, DM, DFF}; S.init(g.M, g.N, (int)gridDim.x, (int)blockIdx.x);
            fix_panels(p, l, S);
            EpiRes E{R3, l == NLAYER - 1 ? R2 : XBUF, SS1};
            gemm_phase<EpiRes, StaticOrder, false>(lds, g, S, E, nullptr); }
        MK_SYNC();
    }
    phase_final(p);
}

extern "C" void kernel_launch(void* const* d_in, const int* in_sizes, int n_in, void* d_out, int out_size, void* d_ws, size_t ws_size, hipStream_t stream) {
    constexpr size_t kDynLds = 160 * 1024;
    static int grid_blocks = 0;
    if (!grid_blocks) {
        (void)hipFuncSetAttribute((const void*)fwd_megakernel, hipFuncAttributeMaxDynamicSharedMemorySize, (int)kDynLds);
        int dev = 0, cus = 0, per_cu = 0;
        (void)hipGetDevice(&dev);
        (void)hipDeviceGetAttribute(&cus, hipDeviceAttributeMultiprocessorCount, dev);
        (void)hipOccupancyMaxActiveBlocksPerMultiprocessor(&per_cu, fwd_megakernel, 512, kDynLds);
        grid_blocks = cus * per_cu;
        if (grid_blocks > 256) grid_blocks = 256;
    }
    if (ws_size < OFF_END) { fprintf(stderr, "workspace too small\n"); return; }
    Params p{};
    p.x_prompt = (const float*)d_in[0]; p.x_sample = (const float*)d_in[1]; p.norm1_g = (const float*)d_in[2]; p.w_in = (const float*)d_in[3]; p.gate_w2 = (const float*)d_in[4];
    p.gate_b = (const float*)d_in[5]; p.gla_norm_g = (const float*)d_in[6]; p.sgu_ln_g = (const float*)d_in[7]; p.sgu_ln_b = (const float*)d_in[8]; p.sgu_w = (const float*)d_in[9];
    p.sgu_b = (const float*)d_in[10]; p.pool_w = (const float*)d_in[11]; p.pool_scale = (const float*)d_in[12]; p.w_o = (const float*)d_in[13]; p.norm2_g = (const float*)d_in[14];
    p.w_ffn_in = (const float*)d_in[15]; p.conv_w = (const float*)d_in[16]; p.conv_b = (const float*)d_in[17]; p.w_ffn_out = (const float*)d_in[18]; p.norm_f = (const float*)d_in[19];
    p.out = (float*)d_out; p.ws = (unsigned char*)d_ws;
    (void)hipMemsetAsync((char*)d_ws + OFF_BAR, 0, 16384, stream);
    void* args[] = {&p};
    hipError_t e = hipLaunchCooperativeKernel((void*)fwd_megakernel, dim3(grid_blocks), dim3(512), args, kDynLds, stream);
    if (e != hipSuccess) fprintf(stderr, "cooperative launch failed: %s (grid %d)\n", hipGetErrorString(e), grid_blocks);
}
```

```cpp
#include <hip/hip_runtime.h>
#include <hip/hip_cooperative_groups.h>
#include <cstdio>
namespace cg = cooperative_groups;
namespace pg8 {
#define PG8_LAS __attribute__((address_space(3)))
typedef unsigned short bf16_t;
typedef short bf16x8 __attribute__((ext_vector_type(8)));
typedef float f32x4 __attribute__((ext_vector_type(4)));
typedef unsigned u32x4 __attribute__((ext_vector_type(4)));
constexpr int BM = 256, BK = 64, HALF = 128, HTB = HALF * BK * 2  , STAGE_BYTES = 8 * HTB, NXCD = 8, WGM = 8;

__host__ __device__ __forceinline__ int lds_byte(int r, int c) { const int st = (r >> 4) * 2 + (c >> 5), rr = r & 15, cc = c & 31, ob = rr * 64 + cc * 2; return st * 1024 + (ob ^ (((ob >> 9) & 1) << 5)); }
__host__ __device__ __forceinline__ void stage_rc(int b, int& R, int& C) { const int st = b / 1024, sb = b % 1024, swz = sb ^ (((sb >> 9) & 1) << 5); R = (st >> 1) * 16 + swz / 64; C = (st & 1) * 32 + (swz % 64) / 2; }
__host__ __device__ __forceinline__ int perm32(int rho) { const int n = rho >> 4, i = rho & 15; return 8 * (i >> 2) + 4 * n + (i & 3); }

struct Unit { int pm, pn; };
struct Gemm { const bf16_t* A; const bf16_t* Bt; int M, N, K; };

struct StaticOrder {
    int nM, nN, nwg, G, c;
    __host__ __device__ void init(int M, int N, int G_, int c_) { nM = M / BM; nN = N / BM; nwg = nM * nN; G = G_; c = c_; }
    __host__ __device__ bool next(int i, Unit& u) const {
        const long L = (long)i * G + c; if (L >= nwg) return false;
        int wgid = (int)L; { const int q = nwg / NXCD, r = nwg % NXCD, xcd = wgid % NXCD, off = wgid / NXCD; wgid = (xcd < r ? xcd * (q + 1) : r * (q + 1) + (xcd - r) * q) + off; }
        const int nig = WGM * nN, gid = wgid / nig, fm = gid * WGM, gsz = (nM - fm) < WGM ? (nM - fm) : WGM;
        u.pm = fm + ((wgid % nig) % gsz); u.pn = (wgid % nig) / gsz; return true;
    }
    __device__ __forceinline__ void a_ready(const Unit&) const {}
    __device__ __forceinline__ void done(const Unit&) const {}
};
typedef __bf16 bf16x2_hw __attribute__((ext_vector_type(2)));
typedef float f32x2_hw __attribute__((ext_vector_type(2)));
__device__ __forceinline__ unsigned cvt_pk_bf16(float lo, float hi) { const f32x2_hw v = {lo, hi}; const bf16x2_hw r = __builtin_convertvector(v, bf16x2_hw); return __builtin_bit_cast(unsigned, r); }
template <class Epi, class Sched, bool STAMP = false>
__device__ __forceinline__ void gemm_phase(PG8_LAS unsigned char* lds, const Gemm g, const Sched& S, const Epi& E, unsigned long long* stamps) {
    int tid_l = threadIdx.x; asm volatile("" : "+v"(tid_l));
    const int tid = tid_l, wid = __builtin_amdgcn_readfirstlane(tid >> 6), lane = tid & 63, wr = wid >> 2, wc = wid & 3, fr = lane & 15, fq = lane >> 4;
    const int K = g.K, nt = K / BK;
    int ts_lo = 0, ts_hi = 0, nts = 0; const unsigned long long rt_entry = STAMP ? (unsigned long long)wall_clock64() : 0ull;
#define PG8_STAMP() do { if (STAMP && wid == 0 && nts < 64) { const unsigned long long _c = (unsigned long long)clock64(); \
        ts_lo = (lane == nts) ? (int)(unsigned)_c : ts_lo; ts_hi = (lane == nts) ? (int)(unsigned)(_c >> 32) : ts_hi; ++nts; } } while (0)
    PG8_STAMP();
    unsigned voffA[2], voffB[2];
#pragma unroll
    for (int i = 0; i < 2; ++i) { int R, C; stage_rc(tid * 16 + i * 8192, R, C); const int Rb = Epi::PERM ? ((R & ~31) + perm32(R & 31)) : R;
        voffA[i] = (unsigned)(R * K + C) * 2u; voffB[i] = (unsigned)(Rb * K + C) * 2u; }
    const size_t kstep = (size_t)(BK * 2);
    const size_t hstep = (size_t)HALF * K * 2;
    const size_t tstep = 2 * hstep;
    const unsigned ldsw = (unsigned)wid * 1024u;
    const int aoff = lds_byte(wr * 64 + fr, fq * 8), boff = lds_byte(wc * 32 + fr, fq * 8);
#define PG8_SA(b, h) (((b) * 2 + (h)) * HTB)
#define PG8_SB(b, h) ((4 + (b) * 2 + (h)) * HTB)
#define PG8_STAGE(bufoff, gbase, voff) do { _Pragma("unroll") for (int _i = 0; _i < 2; ++_i) \
        __builtin_amdgcn_global_load_lds((const unsigned*)((const char*)(gbase) + (voff)[_i]), (PG8_LAS unsigned*)(lds + (bufoff) + ldsw + _i * 8192), 16, 0, 0); } while (0)
#define PG8_LDA(dst, b, h) do { _Pragma("unroll") for (int m = 0; m < 4; ++m) _Pragma("unroll") for (int k = 0; k < 2; ++k) dst[m][k] = *(const PG8_LAS bf16x8*)(lds + PG8_SA(b, h) + aoff + m * 2048 + k * 1024); } while (0)
#define PG8_LDB(dst, b, h) do { _Pragma("unroll") for (int n = 0; n < 2; ++n) _Pragma("unroll") for (int k = 0; k < 2; ++k) dst[n][k] = *(const PG8_LAS bf16x8*)(lds + PG8_SB(b, h) + boff + n * 2048 + k * 1024); } while (0)
#define PG8_MMA(ai, bj, At, Bt) do { __builtin_amdgcn_s_setprio(1); _Pragma("unroll") for (int m = 0; m < 4; ++m) _Pragma("unroll") for (int n = 0; n < 2; ++n) _Pragma("unroll") for (int k = 0; k < 2; ++k) \
        acc[ai][bj][m][n] = __builtin_amdgcn_mfma_f32_16x16x32_bf16(Bt[n][k], At[m][k], acc[ai][bj][m][n], 0, 0, 0); __builtin_amdgcn_s_setprio(0); } while (0)
#define PG8_WAIT_V(n) asm volatile("s_waitcnt vmcnt(" #n ")" ::: "memory")
#define PG8_WAIT_L(n) asm volatile("s_waitcnt lgkmcnt(" #n ")" ::: "memory")
#define PG8_BAR __builtin_amdgcn_s_barrier()
#define PG8_SCHED __builtin_amdgcn_sched_barrier(0)
    Unit cur, nxt; int ui = 0;
    if (!S.next(0, cur)) return;
    f32x4 acc[2][2][4][2];
#pragma unroll
    for (int a = 0; a < 2; ++a)
#pragma unroll
        for (int b = 0; b < 2; ++b)
#pragma unroll
            for (int m = 0; m < 4; ++m)
#pragma unroll
                for (int n = 0; n < 2; ++n) acc[a][b][m][n] = (f32x4){0.f, 0.f, 0.f, 0.f};
    bf16x8 At[4][2], B0[2][2], B1[2][2];
    const char* cA = (const char*)g.A + (size_t)cur.pm * tstep; const char* cB = (const char*)g.Bt + (size_t)cur.pn * tstep;
    S.a_ready(cur);
    PG8_STAGE(PG8_SB(0, 0), cB, voffB); PG8_STAGE(PG8_SA(0, 0), cA, voffA); PG8_STAGE(PG8_SB(0, 1), cB + hstep, voffB); PG8_STAGE(PG8_SA(0, 1), cA + hstep, voffA);
    if (wr == 1) PG8_BAR;
    PG8_WAIT_V(4); PG8_BAR;
    PG8_STAGE(PG8_SB(1, 0), cB + kstep, voffB); PG8_STAGE(PG8_SA(1, 0), cA + kstep, voffA); PG8_STAGE(PG8_SB(1, 1), cB + hstep + kstep, voffB);
    PG8_WAIT_V(6); PG8_BAR;
    PG8_STAMP();
    for (;;) {
        const bool has_next = S.next(ui + 1, nxt);
        const char* nA = has_next ? (const char*)g.A + (size_t)nxt.pm * tstep : cA; const char* nB = has_next ? (const char*)g.Bt + (size_t)nxt.pn * tstep : cB;
        for (int t = 0; t < nt; t += 2) {
            const bool last = (t == nt - 2);
            const char* a1 = cA + (size_t)(t + 1) * kstep;
            const char* a2 = last ? nA : cA + (size_t)(t + 2) * kstep; const char* b2 = last ? nB : cB + (size_t)(t + 2) * kstep;
            const char* a3 = a2 + kstep; const char* b3 = b2 + kstep;
            if (last && has_next) S.a_ready(nxt);
            PG8_LDB(B0, 0, 0); PG8_SCHED; PG8_LDA(At, 0, 0); PG8_STAGE(PG8_SA(1, 1), a1 + hstep, voffA);
            PG8_WAIT_L(8); PG8_BAR; PG8_WAIT_L(0); PG8_MMA(0, 0, At, B0); PG8_BAR; PG8_SCHED;
            PG8_LDB(B1, 0, 1); PG8_STAGE(PG8_SB(0, 0), b2, voffB);
            PG8_BAR; PG8_WAIT_L(0); PG8_MMA(0, 1, At, B1); PG8_BAR;
            PG8_LDA(At, 0, 1); PG8_STAGE(PG8_SA(0, 0), a2, voffA);
            PG8_BAR; PG8_WAIT_L(0); PG8_MMA(1, 0, At, B0); PG8_BAR; PG8_SCHED;
            PG8_STAGE(PG8_SB(0, 1), b2 + hstep, voffB);
            PG8_WAIT_V(6); PG8_BAR; PG8_MMA(1, 1, At, B1); PG8_BAR;
            PG8_LDB(B0, 1, 0); PG8_SCHED; PG8_LDA(At, 1, 0); PG8_STAGE(PG8_SA(0, 1), a2 + hstep, voffA);
            PG8_WAIT_L(8); PG8_BAR; PG8_WAIT_L(0); PG8_MMA(0, 0, At, B0); PG8_BAR; PG8_SCHED;
            PG8_LDB(B1, 1, 1); PG8_STAGE(PG8_SB(1, 0), b3, voffB);
            PG8_BAR; PG8_WAIT_L(0); PG8_MMA(0, 1, At, B1); PG8_BAR;
            PG8_LDA(At, 1, 1); PG8_STAGE(PG8_SA(1, 0), a3, voffA);
            PG8_BAR; PG8_WAIT_L(0); PG8_MMA(1, 0, At, B0); PG8_BAR; PG8_SCHED;
            PG8_STAGE(PG8_SB(1, 1), b3 + hstep, voffB);
            PG8_WAIT_V(6); PG8_BAR; PG8_MMA(1, 1, At, B1); PG8_BAR;
        }
        PG8_STAMP();
        if constexpr (!Epi::AFTER_DRAIN) { E(acc, cur, ui, lds, wr, wc, fr, fq); S.done(cur); }
        PG8_STAMP();
        if (!has_next) break;
#pragma unroll
        for (int a = 0; a < 2; ++a)
#pragma unroll
            for (int b = 0; b < 2; ++b)
#pragma unroll
                for (int m = 0; m < 4; ++m)
#pragma unroll
                    for (int n = 0; n < 2; ++n) acc[a][b][m][n] = (f32x4){0.f, 0.f, 0.f, 0.f};
        cur = nxt; cA = nA; cB = nB; ++ui;
    }
    PG8_WAIT_V(0);
    if (wr == 0) PG8_BAR;
    PG8_BAR;
    if constexpr (Epi::AFTER_DRAIN) { E.fused(acc, cur, wr, wc, fr, fq, lds, wid, lane); S.done(cur); }
    PG8_STAMP();
    if (STAMP && wid == 0) { stamps[lane] = lane < nts ? (((unsigned long long)(unsigned)ts_hi << 32) | (unsigned)ts_lo) : 0ull;
        if (lane == 62) stamps[62] = rt_entry; if (lane == 63) stamps[63] = (unsigned long long)wall_clock64(); }
#undef PG8_STAMP
#undef PG8_SA
#undef PG8_SB
#undef PG8_STAGE
#undef PG8_LDA
#undef PG8_LDB
#undef PG8_MMA
#undef PG8_WAIT_V
#undef PG8_WAIT_L
#undef PG8_BAR
#undef PG8_SCHED
}
}
using namespace pg8;
typedef unsigned u32x2 __attribute__((ext_vector_type(2)));
typedef float f32x2v __attribute__((ext_vector_type(2)));
#define LAS PG8_LAS

constexpr int T_TOK = 65536, DM = 1024, NIN = 2816, DFF = 2816, NLAYER = 4, INW = 2336;
constexpr int PC_Q = 0, PC_K = 256, PC_V = 512, PC_G = 1024, PC_XP = 1536, PC_U = 1792, PC_VS = 2048, PC_ZF = 2304, PC_ZB = 2560;
constexpr float EPSF = 1e-6f;
__device__ __forceinline__ size_t kv_idx(int gc, int h, int dir) { return (size_t)(h * 2 + dir) * 1024 + gc; }
constexpr size_t WB_IN = 0, WB_O = (size_t)NIN * DM, WB_1 = WB_O + (size_t)DM * DM, WB_2 = WB_1 + (size_t)2 * DFF * DM, WB_LAYER = WB_2 + (size_t)DM * DFF;
constexpr size_t OFF_WB = 0;
constexpr size_t OFF_R1 = OFF_WB + WB_LAYER * 2 * NLAYER;
constexpr size_t OFF_R2 = OFF_R1 + (size_t)T_TOK * NIN * 2;
constexpr size_t OFF_R3 = OFF_R2 + (size_t)T_TOK * DM * 2;
constexpr size_t OFF_SS1 = OFF_R3 + (size_t)T_TOK * DM * 2;
constexpr size_t OFF_SS2 = OFF_SS1 + (size_t)T_TOK * 16 * 4;
constexpr size_t OFF_DEC = OFF_SS2 + (size_t)T_TOK * 16 * 4;
constexpr size_t OFF_BAR = OFF_DEC + (size_t)8192 * 64 * 4;
constexpr size_t OFF_END = OFF_BAR + 16384;

struct Params {
    const float* x_prompt; const float* x_sample; const float* norm1_g; const float* w_in; const float* gate_w2; const float* gate_b; const float* gla_norm_g;
    const float* sgu_ln_g; const float* sgu_ln_b; const float* sgu_w; const float* sgu_b; const float* pool_w; const float* pool_scale; const float* w_o; const float* norm2_g;
    const float* w_ffn_in; const float* conv_w; const float* conv_b; const float* w_ffn_out; const float* norm_f;
    float* out; unsigned char* ws;
};

__device__ __forceinline__ unsigned short f2bf(float f) { return (unsigned short)cvt_pk_bf16(f, 0.f); }
__device__ __forceinline__ float bf2f(unsigned short b) { return __uint_as_float(((unsigned)b) << 16); }
__device__ __forceinline__ float bflo(unsigned w) { return __uint_as_float(w << 16); }
__device__ __forceinline__ float bfhi(unsigned w) { return __uint_as_float(w & 0xffff0000u); }
__device__ __forceinline__ float siluf_(float x) { return x * __builtin_amdgcn_rcpf(1.0f + __builtin_amdgcn_exp2f(-1.44269504f * x)); }
__device__ __forceinline__ float gelu_tanh(float x) { const float y = x * (2.30220819f + 0.10294324f * x * x); return x * __builtin_amdgcn_rcpf(1.0f + __builtin_amdgcn_exp2f(-y)); }
__device__ __forceinline__ float logsigmoidf_(float z) { return fminf(z, 0.f) - 0.69314718f * __builtin_amdgcn_logf(1.0f + __builtin_amdgcn_exp2f(-1.44269504f * fabsf(z))); }
__device__ __forceinline__ float sum16(const float* p) { const f32x4 a = *(const f32x4*)p, b = *(const f32x4*)(p + 4), c = *(const f32x4*)(p + 8), d = *(const f32x4*)(p + 12);
    return ((a[0] + a[1]) + (a[2] + a[3])) + ((b[0] + b[1]) + (b[2] + b[3])) + ((c[0] + c[1]) + (c[2] + c[3])) + ((d[0] + d[1]) + (d[2] + d[3])); }

__device__ __forceinline__ void unpack8(const u32x4 w, float (&f)[8]) { f[0] = bflo(w.x); f[1] = bfhi(w.x); f[2] = bflo(w.y); f[3] = bfhi(w.y); f[4] = bflo(w.z); f[5] = bfhi(w.z); f[6] = bflo(w.w); f[7] = bfhi(w.w); }
constexpr int RS_LDS = 131072;
template <class Sched> __device__ __forceinline__ void precompute_rs(LAS unsigned char* lds, const Sched& S, const float* ss, int slot0 = 0, bool sync = true) {
    int tid_l = threadIdx.x; asm volatile("" : "+v"(tid_l)); const int tid = tid_l;
    Unit u; int nU = 0;
    while (S.next(nU, u)) ++nU;
    const int r = tid & 255;
#pragma unroll 4
    for (int i = tid >> 8; i < nU; i += 2) { S.next(i, u);
        const float t = sum16(ss + (size_t)(u.pm * BM + r) * 16); *(LAS float*)(lds + RS_LDS + ((slot0 + i) * 256 + r) * 4) = rsqrtf(t * (1.0f / 1024.0f) + EPSF); }
    if (sync) __syncthreads();
}
template <int MODE  > struct EpiIn {
    static constexpr bool PERM = true, AFTER_DRAIN = false;
    bf16_t* P; const float* gbias; int colbase, slot0;
    __device__ __forceinline__ void operator()(const f32x4 (&acc)[2][2][4][2], const Unit& u, int ui, LAS unsigned char* lds, int wr, int wc, int fr, int fq) const {
        const int row0 = u.pm * BM + wr * 64 + fr, cl = wc * 32 + 8 * fq, col0 = colbase + u.pn * BM + cl;
        float bias[2][8];
#pragma unroll
        for (int bj = 0; bj < 2; ++bj)
#pragma unroll
            for (int j = 0; j < 8; ++j) bias[bj][j] = 0.f;
        if (MODE == 2) {
#pragma unroll
            for (int bj = 0; bj < 2; ++bj) { const f32x4 b0 = *(const f32x4*)(gbias + u.pn * 256 + cl + bj * HALF), b1 = *(const f32x4*)(gbias + u.pn * 256 + cl + bj * HALF + 4);
#pragma unroll
                for (int j = 0; j < 4; ++j) { bias[bj][j] = b0[j]; bias[bj][4 + j] = b1[j]; } }
        }
        float rsv[8];
#pragma unroll
        for (int it = 0; it < 8; ++it) rsv[it] = *(const LAS float*)(lds + RS_LDS + ((slot0 + ui) * 256 + wr * 64 + fr + (it >> 2) * HALF + (it & 3) * 16) * 4);
#pragma unroll
        for (int ai = 0; ai < 2; ++ai)
#pragma unroll
            for (int m = 0; m < 4; ++m) {
                int row = row0 + ai * HALF + m * 16; asm volatile("" : "+v"(row));
                const float rs = rsv[ai * 4 + m];
                bf16_t* rowp = P + (size_t)row * NIN + col0;
#pragma unroll
                for (int bj = 0; bj < 2; ++bj) {
                    float v[8];
#pragma unroll
                    for (int j = 0; j < 4; ++j) { v[j] = acc[ai][bj][m][0][j] * rs; v[4 + j] = acc[ai][bj][m][1][j] * rs; }
                    if (MODE == 1) {
#pragma unroll
                        for (int j = 0; j < 8; ++j) v[j] = gelu_tanh(v[j]);
                    } else if (MODE == 2) {
#pragma unroll
                        for (int j = 0; j < 8; ++j) v[j] = logsigmoidf_(v[j] + bias[bj][j]) * (1.44269504f / 16.0f);
                    }
                    u32x4 w; w.x = cvt_pk_bf16(v[0], v[1]); w.y = cvt_pk_bf16(v[2], v[3]); w.z = cvt_pk_bf16(v[4], v[5]); w.w = cvt_pk_bf16(v[6], v[7]);
                    *(u32x4*)(rowp + bj * HALF) = w;
                }
            }
    }
};
struct EpiRes {
    static constexpr bool PERM = true, AFTER_DRAIN = false;
    const bf16_t* xs; bf16_t* xb; float* ss;
    __device__ __forceinline__ void operator()(const f32x4 (&acc)[2][2][4][2], const Unit& u, int ui, LAS unsigned char* lds, int wr, int wc, int fr, int fq) const {
        const int row0 = u.pm * BM + wr * 64 + fr, col0 = u.pn * BM + wc * 32 + 8 * fq;
        u32x4 xc[2], xn[2];
        { int row = row0; asm volatile("" : "+v"(row)); const bf16_t* xr = xs + (size_t)row * DM + col0; xc[0] = *(const u32x4*)(xr); xc[1] = *(const u32x4*)(xr + HALF); }
#pragma unroll
        for (int it = 0; it < 8; ++it) {
            const int ai = it >> 2, m = it & 3;
            if (it < 7) { int rown = row0 + ((it + 1) >> 2) * HALF + ((it + 1) & 3) * 16; asm volatile("" : "+v"(rown)); const bf16_t* xr = xs + (size_t)rown * DM + col0;
                xn[0] = *(const u32x4*)(xr); xn[1] = *(const u32x4*)(xr + HALF); }
            int row = row0 + ai * HALF + m * 16; asm volatile("" : "+v"(row));
            bf16_t* bw = xb + (size_t)row * DM + col0;
            float sq = 0.f;
#pragma unroll
            for (int bj = 0; bj < 2; ++bj) {
                float x[8]; unpack8(xc[bj], x);
                u32x4 w;
                w.x = cvt_pk_bf16(acc[ai][bj][m][0][0] + x[0], acc[ai][bj][m][0][1] + x[1]); w.y = cvt_pk_bf16(acc[ai][bj][m][0][2] + x[2], acc[ai][bj][m][0][3] + x[3]);
                w.z = cvt_pk_bf16(acc[ai][bj][m][1][0] + x[4], acc[ai][bj][m][1][1] + x[5]); w.w = cvt_pk_bf16(acc[ai][bj][m][1][2] + x[6], acc[ai][bj][m][1][3] + x[7]);
                *(u32x4*)(bw + bj * HALF) = w;
                float r[8]; unpack8(w, r);
                sq += (r[0] * r[0] + r[1] * r[1]) + (r[2] * r[2] + r[3] * r[3]) + (r[4] * r[4] + r[5] * r[5]) + (r[6] * r[6] + r[7] * r[7]);
            }
            sq += __shfl_xor(sq, 16); sq += __shfl_xor(sq, 32);
            if (fq == 0) ss[(size_t)row * 16 + u.pn * 4 + wc] = sq;
            xc[0] = xn[0]; xc[1] = xn[1];
        }
    }
};
__device__ __forceinline__ float dpp_prev(float x) { return __builtin_bit_cast(float, __builtin_amdgcn_update_dpp(0, __builtin_bit_cast(int, x), 0x121, 0xf, 0xf, false)); }
__device__ __forceinline__ float dpp_next(float x) { return __builtin_bit_cast(float, __builtin_amdgcn_update_dpp(0, __builtin_bit_cast(int, x), 0x12F, 0xf, 0xf, false)); }
struct EpiFfn {
    static constexpr bool PERM = true, AFTER_DRAIN = false;
    bf16_t* act; const float* ss; const float* cw; const float* cb; float* side;
    __device__ __forceinline__ void operator()(const f32x4 (&acc)[2][2][4][2], const Unit& u, int ui, LAS unsigned char* lds, int wr, int wc, int fr, int fq) const {
#pragma unroll
        for (int ai = 0; ai < 2; ++ai) {
            int blk = u.pm * 4 + ai * 2 + wr; asm volatile("" : "+s"(blk));
            const int rbase = blk * 64;
            int ca0 = u.pn * 128 + wc * 32 + 8 * fq; asm volatile("" : "+v"(ca0));
            float rs[4];
#pragma unroll
            for (int m = 0; m < 4; ++m) rs[m] = *(const LAS float*)(lds + RS_LDS + (ui * 256 + ai * HALF + wr * 64 + 16 * m + fr) * 4);
            float* sd = side + (size_t)blk * 6 * DFF + ca0;
#pragma unroll
            for (int n = 0; n < 2; ++n) {
                const f32x4 w0 = *(const f32x4*)(cw + ca0 + 4 * n), w1 = *(const f32x4*)(cw + DFF + ca0 + 4 * n), w2 = *(const f32x4*)(cw + 2 * DFF + ca0 + 4 * n), bb = *(const f32x4*)(cb + ca0 + 4 * n);
                unsigned pk[4][2];
#pragma unroll
                for (int jp = 0; jp < 2; ++jp) {
                    const f32x2v w0v = {w0[2 * jp], w0[2 * jp + 1]}, w1v = {w1[2 * jp], w1[2 * jp + 1]}, w2v = {w2[2 * jp], w2[2 * jp + 1]}, bbv = {bb[2 * jp], bb[2 * jp + 1]};
                    f32x2v a[4], up[4], ps[4], ns[4];
#pragma unroll
                    for (int m = 0; m < 4; ++m) { a[m] = (f32x2v){acc[ai][0][m][n][2 * jp], acc[ai][0][m][n][2 * jp + 1]} * rs[m]; up[m] = (f32x2v){acc[ai][1][m][n][2 * jp], acc[ai][1][m][n][2 * jp + 1]} * rs[m]; }
#pragma unroll
                    for (int m = 0; m < 4; ++m) { ps[m].x = dpp_prev(a[m].x); ps[m].y = dpp_prev(a[m].y); ns[m].x = dpp_next(a[m].x); ns[m].y = dpp_next(a[m].y); }
#pragma unroll
                    for (int m = 0; m < 4; ++m) {
                        const f32x2v zero = {0.f, 0.f};
                        const f32x2v pv = (fr == 0) ? (m > 0 ? ps[m > 0 ? m - 1 : 0] : zero) : ps[m];
                        const f32x2v nv = (fr == 15) ? (m < 3 ? ns[m < 3 ? m + 1 : 3] : zero) : ns[m];
                        const f32x2v z = w0v * pv + (w1v * a[m] + (w2v * nv + bbv));
                        const f32x2v t = z * (-1.44269504f);
                        f32x2v e; e.x = __builtin_amdgcn_exp2f(t.x); e.y = __builtin_amdgcn_exp2f(t.y);
                        const f32x2v d = e + 1.0f;
                        f32x2v r; r.x = __builtin_amdgcn_rcpf(d.x); r.y = __builtin_amdgcn_rcpf(d.y);
                        const f32x2v o = (z * r) * up[m];
                        pk[m][jp] = cvt_pk_bf16(o.x, o.y);
                        if (m == 0 && fr == 0) { *(f32x2v*)(sd + 4 * n + 2 * jp) = z; *(f32x2v*)(sd + DFF + 4 * n + 2 * jp) = up[0]; *(f32x2v*)(sd + 2 * DFF + 4 * n + 2 * jp) = a[0]; }
                        if (m == 3 && fr == 15) { *(f32x2v*)(sd + 3 * DFF + 4 * n + 2 * jp) = z; *(f32x2v*)(sd + 4 * DFF + 4 * n + 2 * jp) = up[3]; *(f32x2v*)(sd + 5 * DFF + 4 * n + 2 * jp) = a[3]; }
                    }
                }
#pragma unroll
                for (int m = 0; m < 4; ++m) {
                    const bool boundary = (m == 0 && fr == 0) || (m == 3 && fr == 15);
                    if (!boundary) { u32x2 w; w.x = pk[m][0]; w.y = pk[m][1]; *(u32x2*)(act + (size_t)(rbase + 16 * m + fr) * DFF + ca0 + 4 * n) = w; }
                }
            }
        }
    }
};

__device__ __forceinline__ bf16x8 lds_frag(LAS unsigned char* lds, int off_bytes) { return *(const LAS bf16x8*)(lds + off_bytes); }
#define MFMA16(a, b, c) __builtin_amdgcn_mfma_f32_16x16x32_bf16((a), (b), (c), 0, 0, 0)
__device__ __forceinline__ void seq_of(int t, int& s0, int& S) { if (t < 32768) { S = 2048; s0 = t & ~2047; } else { S = 16384; s0 = 32768 + ((t - 32768) & ~16383); } }

__device__ void phase_prep(const Params& p, LAS unsigned char* lds) {
    int tid_l = threadIdx.x; asm volatile("" : "+v"(tid_l)); const int tid = tid_l;
    LAS float* tile = (LAS float*)lds;
    bf16_t* WB = (bf16_t*)(p.ws + OFF_WB);
    constexpr int TPL = 704 + 256 + 1408 + 704;
    for (int it = blockIdx.x; it < TPL * NLAYER; it += gridDim.x) {
        const int l = it / TPL; int r = it % TPL;
        const float* src; int ld; int srccol; const float* gk; bf16_t* dst; int K; int n0, k0; bool comp = false; int cdir = 0, cc0 = 0;
        if (r < 704) { const int nt = r / 16, kt = r % 16; n0 = nt * 64; k0 = kt * 64; K = DM; src = p.w_in + (size_t)l * DM * INW; ld = INW; gk = p.norm1_g + l * DM; dst = WB + l * WB_LAYER + WB_IN;
            if (n0 < 1536) srccol = n0; else if (n0 < 1792) srccol = n0 + 544; else if (n0 < 2304) srccol = n0 - 224; else { comp = true; cdir = (n0 - 2304) / 256; cc0 = (n0 - 2304) % 256; srccol = 0; } }
        else if (r < 960) { r -= 704; const int nt = r / 16, kt = r % 16; n0 = nt * 64; k0 = kt * 64; K = DM; src = p.w_o + (size_t)l * DM * DM; ld = DM; gk = nullptr; dst = WB + l * WB_LAYER + WB_O; srccol = n0; }
        else if (r < 2368) { r -= 960; const int nt = r / 16, kt = r % 16; n0 = nt * 64; k0 = kt * 64; K = DM; src = p.w_ffn_in + (size_t)l * DM * 2 * DFF; ld = 2 * DFF; gk = p.norm2_g + l * DM; dst = WB + l * WB_LAYER + WB_1;
            const int pn = n0 / 256, within = n0 % 256; srccol = within < 128 ? pn * 128 + within : DFF + pn * 128 + (within - 128); }
        else { r -= 2368; const int nt = r / 44, kt = r % 44; n0 = nt * 64; k0 = kt * 64; K = DFF; src = p.w_ffn_out + (size_t)l * DFF * DM; ld = DM; gk = nullptr; dst = WB + l * WB_LAYER + WB_2; srccol = n0; }
        if (!comp) {
            const int kk = tid >> 4, nn4 = (tid & 15) * 4;
#pragma unroll
            for (int h = 0; h < 2; ++h) { const int k = kk + 32 * h; const f32x4 v = *(const f32x4*)(src + (size_t)(k0 + k) * ld + srccol + nn4);
                tile[k * 65 + nn4] = v[0]; tile[k * 65 + nn4 + 1] = v[1]; tile[k * 65 + nn4 + 2] = v[2]; tile[k * 65 + nn4 + 3] = v[3]; }
        } else {
            const int kk = tid >> 3, nn8 = (tid & 7) * 8;
            const float* lr = src + (size_t)(k0 + kk) * ld + 1536 + cdir * 16;
            const float* w2 = p.gate_w2 + ((size_t)(l * 2 + cdir) * 16) * 256 + cc0 + nn8;
            float a[8];
#pragma unroll
            for (int j = 0; j < 8; ++j) a[j] = 0.f;
            for (int rr = 0; rr < 16; ++rr) { const float lv = lr[rr]; const f32x4 x0 = *(const f32x4*)(w2 + rr * 256), x1 = *(const f32x4*)(w2 + rr * 256 + 4);
#pragma unroll
                for (int j = 0; j < 4; ++j) { a[j] += lv * x0[j]; a[4 + j] += lv * x1[j]; } }
#pragma unroll
            for (int j = 0; j < 8; ++j) tile[kk * 65 + nn8 + j] = a[j];
        }
        __syncthreads();
        {
            const int nn = tid >> 3, kk8 = (tid & 7) * 8;
            float v[8];
#pragma unroll
            for (int j = 0; j < 8; ++j) v[j] = tile[(kk8 + j) * 65 + nn] * (gk ? gk[k0 + kk8 + j] : 1.0f);
            u32x4 w; w.x = cvt_pk_bf16(v[0], v[1]); w.y = cvt_pk_bf16(v[2], v[3]); w.z = cvt_pk_bf16(v[4], v[5]); w.w = cvt_pk_bf16(v[6], v[7]);
            *(u32x4*)(dst + (size_t)(n0 + nn) * K + k0 + kk8) = w;
        }
        __syncthreads();
    }
    bf16_t* XB = (bf16_t*)p.out; float* SS1 = (float*)(p.ws + OFF_SS1);
    const int wid = tid >> 6, lane = tid & 63;
    for (int row0 = (blockIdx.x * 8 + wid) * 4; row0 < T_TOK; row0 += gridDim.x * 32) {
        f32x4 v[4][4];
#pragma unroll
        for (int r = 0; r < 4; ++r) { const int row = row0 + r; const float* xr = row < 32768 ? p.x_prompt + (size_t)row * DM : p.x_sample + (size_t)(row - 32768) * DM;
#pragma unroll
            for (int h = 0; h < 2; ++h) { v[r][2 * h] = *(const f32x4*)(xr + h * 512 + lane * 8); v[r][2 * h + 1] = *(const f32x4*)(xr + h * 512 + lane * 8 + 4); } }
#pragma unroll
        for (int r = 0; r < 4; ++r) { const int row = row0 + r;
            float sq = 0.f;
#pragma unroll
            for (int h = 0; h < 2; ++h) {
                const f32x4 v0 = v[r][2 * h], v1 = v[r][2 * h + 1];
                u32x4 w; w.x = cvt_pk_bf16(v0[0], v0[1]); w.y = cvt_pk_bf16(v0[2], v0[3]); w.z = cvt_pk_bf16(v1[0], v1[1]); w.w = cvt_pk_bf16(v1[2], v1[3]);
                *(u32x4*)(XB + (size_t)row * DM + h * 512 + lane * 8) = w;
                float q[8]; unpack8(w, q);
                sq += (q[0] * q[0] + q[1] * q[1]) + (q[2] * q[2] + q[3] * q[3]) + (q[4] * q[4] + q[5] * q[5]) + (q[6] * q[6] + q[7] * q[7]);
            }
#pragma unroll
            for (int o = 1; o < 64; o <<= 1) sq += __shfl_xor(sq, o);
            if (lane < 16) SS1[(size_t)row * 16 + lane] = lane == 0 ? sq : 0.f;
        }
    }
}

template <int CTRL, int ROWMASK, bool BOUND> __device__ __forceinline__ float dpp_add(float v) {
    return v + __builtin_bit_cast(float, __builtin_amdgcn_update_dpp(0, __builtin_bit_cast(int, v), CTRL, ROWMASK, 0xf, BOUND));
}
__device__ __forceinline__ float wave_prefix(float v) {
    v = dpp_add<0x111, 0xf, true>(v); v = dpp_add<0x112, 0xf, true>(v); v = dpp_add<0x114, 0xf, true>(v); v = dpp_add<0x118, 0xf, true>(v);
    v = dpp_add<0x142, 0xa, false>(v); v = dpp_add<0x143, 0xc, false>(v);
    return v;
}
__device__ __forceinline__ void wave_scan16(float (&gf)[8], float (&gb)[8], int lane) {
    (void)lane;
#pragma unroll
    for (int e = 0; e < 8; ++e) {
        gf[e] = wave_prefix(gf[e]);
        const float x = gb[e], pf = wave_prefix(x);
        const float tot = __builtin_bit_cast(float, __builtin_amdgcn_readlane(__builtin_bit_cast(int, pf), 63));
        gb[e] = (tot - pf) + x;
    }
}
__device__ __forceinline__ void lds_put_col8(LAS unsigned char* lds, int base, int row0, int col, const u32x4 w) {
    const unsigned ww[4] = {w.x, w.y, w.z, w.w};
#pragma unroll
    for (int e = 0; e < 8; ++e) *(LAS bf16_t*)(lds + base + ((row0 + e) * 72 + col) * 2) = (bf16_t)((e & 1) ? (ww[e >> 1] >> 16) : (ww[e >> 1] & 0xffffu));
}

struct M1Raw { u32x4 laf, lab, k, v0, v1; };
__device__ __forceinline__ void m1_load(const bf16_t* P, int item, int wid, int lane, M1Raw& r) {
    const int gc = item >> 2, h = item & 3, tid = wid * 64 + lane; const bf16_t* row = P + (size_t)(gc * 64 + (tid >> 3)) * NIN + (tid & 7) * 8;
    r.laf = *(const u32x4*)(row + PC_ZF + h * 64); r.lab = *(const u32x4*)(row + PC_ZB + h * 64); r.k = *(const u32x4*)(row + PC_K + h * 64);
    r.v0 = *(const u32x4*)(P + (size_t)(gc * 64 + (tid >> 4)) * NIN + PC_V + h * 128 + (tid & 15) * 8); r.v1 = *(const u32x4*)(P + (size_t)(gc * 64 + 32 + (tid >> 4)) * NIN + PC_V + h * 128 + (tid & 15) * 8);
}
__device__ __forceinline__ void m1_stage(LAS unsigned char* lds, int base, int tid, const M1Raw& r) {
    const int o = ((tid >> 3) * 72 + (tid & 7) * 8) * 2;
    *(LAS u32x4*)(lds + base + o) = r.laf; *(LAS u32x4*)(lds + base + 9216 + o) = r.lab; *(LAS u32x4*)(lds + base + 18432 + o) = r.k;
    *(LAS u32x4*)(lds + base + 27648 + ((tid >> 4) * 136 + (tid & 15) * 8) * 2) = r.v0; *(LAS u32x4*)(lds + base + 27648 + ((32 + (tid >> 4)) * 136 + (tid & 15) * 8) * 2) = r.v1;
}
__device__ void phase_m1(const Params& p, LAS unsigned char* lds) {
    int tid_l = threadIdx.x; asm volatile("" : "+v"(tid_l)); const int tid = tid_l, wid = tid >> 6, lane = tid & 63, fr = lane & 15, fq = lane >> 4;
    const bf16_t* P = (const bf16_t*)(p.ws + OFF_R1); bf16_t* KV = (bf16_t*)(p.ws + OFF_R3); float* DEC = (float*)(p.ws + OFF_DEC);
    constexpr int KTF = 0, KTB = 9216, VT = 18432, OUT = 36864, RAW = 73728;
    M1Raw R; int item = blockIdx.x;
    if (item < 4096) m1_load(P, item, wid, lane, R);
    for (; item < 4096; item += gridDim.x) {
        m1_stage(lds, RAW, tid, R);
        if (item + (int)gridDim.x < 4096) m1_load(P, item + gridDim.x, wid, lane, R);
        __syncthreads();
        {
            const int lo = (lane * 72 + wid * 8) * 2;
            float gf[8], gb[8], k[8]; unpack8(*(const LAS u32x4*)(lds + RAW + lo), gf); unpack8(*(const LAS u32x4*)(lds + RAW + 9216 + lo), gb); unpack8(*(const LAS u32x4*)(lds + RAW + 18432 + lo), k);
            const u32x4 rv0 = *(const LAS u32x4*)(lds + RAW + 27648 + (lane * 136 + wid * 8) * 2), rv1 = *(const LAS u32x4*)(lds + RAW + 27648 + (lane * 136 + 64 + wid * 8) * 2);
            float decf[8], decb[8]; unsigned kfp[4], kbp[4];
            wave_scan16(gf, gb, lane);
#pragma unroll
            for (int e = 0; e < 8; ++e) { decf[e] = __shfl(gf[e], 63); decb[e] = __shfl(gb[e], 0); }
#pragma unroll
            for (int e = 0; e < 8; ++e) { const float glf = decf[e], glb = decb[e];
                const float kf = k[e] * __builtin_amdgcn_exp2f(glf - gf[e]), kb = k[e] * __builtin_amdgcn_exp2f(glb - gb[e]);
                *(LAS bf16_t*)(lds + KTF + ((wid * 8 + e) * 72 + lane) * 2) = f2bf(kf); *(LAS bf16_t*)(lds + KTB + ((wid * 8 + e) * 72 + lane) * 2) = f2bf(kb);
                decf[e] = __builtin_amdgcn_exp2f(glf); decb[e] = __builtin_amdgcn_exp2f(glb); }
            (void)kfp; (void)kbp;
            if (lane == 0) { float* df = DEC + kv_idx(item >> 2, item & 3, 0) * 64 + wid * 8; float* db = DEC + kv_idx(item >> 2, item & 3, 1) * 64 + wid * 8;
                *(f32x4*)df = (f32x4){decf[0], decf[1], decf[2], decf[3]}; *(f32x4*)(df + 4) = (f32x4){decf[4], decf[5], decf[6], decf[7]};
                *(f32x4*)db = (f32x4){decb[0], decb[1], decb[2], decb[3]}; *(f32x4*)(db + 4) = (f32x4){decb[4], decb[5], decb[6], decb[7]}; }
            lds_put_col8(lds, VT, wid * 8, lane, rv0); lds_put_col8(lds, VT, 64 + wid * 8, lane, rv1);
        }
        __syncthreads();
        { const int dir = wid >> 2, dt = wid & 3;
            const int abase = (dir ? KTB : KTF) + ((dt * 16 + fr) * 72 + fq * 8) * 2;
            const bf16x8 a0 = lds_frag(lds, abase), a1 = lds_frag(lds, abase + 64);
#pragma unroll
            for (int vt = 0; vt < 8; ++vt) {
                const int bbase = VT + ((vt * 16 + fr) * 72 + fq * 8) * 2;
                f32x4 c = {0.f, 0.f, 0.f, 0.f};
                c = MFMA16(a0, lds_frag(lds, bbase), c); c = MFMA16(a1, lds_frag(lds, bbase + 64), c);
                u32x2 w; w.x = cvt_pk_bf16(c[0], c[1]); w.y = cvt_pk_bf16(c[2], c[3]);
                *(LAS u32x2*)(lds + OUT + dir * 18432 + ((vt * 16 + fr) * 72 + dt * 16 + fq * 4) * 2) = w;
            } }
        __syncthreads();
#pragma unroll
        for (int q = 0; q < 4; ++q) { const int vv = tid + q * 512, dir = vv >> 10, rem = vv & 1023, v = rem >> 3, d8 = (rem & 7) * 8;
            const u32x4 w = *(const LAS u32x4*)(lds + OUT + dir * 18432 + (v * 72 + d8) * 2);
            *(u32x4*)(KV + kv_idx(item >> 2, item & 3, dir) * 8192 + v * 64 + d8) = w; }
    }
}

template <int V, int NB> struct M2Buf { float kv[NB][V], dc[NB][V]; };
template <int V, int NB> __device__ __forceinline__ void m2_ld(M2Buf<V, NB>& B, const bf16_t* KV, const float* DEC, int gc0, int N, int h, int dir, int e, int s0) {
    const int d = e & 63;
#pragma unroll
    for (int b = 0; b < NB; ++b) {
        const int n = dir ? N - 1 - (s0 + b) : (s0 + b); const size_t idx = kv_idx(gc0 + n, h, dir);
        if (V == 4) { const u32x2 w = *(const u32x2*)(KV + idx * 8192 + e); const f32x4 c = *(const f32x4*)(DEC + idx * 64 + d);
            B.kv[b][0] = bflo(w.x); B.kv[b][1 % V] = bfhi(w.x); B.kv[b][2 % V] = bflo(w.y); B.kv[b][3 % V] = bfhi(w.y); B.dc[b][0] = c[0]; B.dc[b][1 % V] = c[1]; B.dc[b][2 % V] = c[2]; B.dc[b][3 % V] = c[3]; }
        else { B.kv[b][0] = bf2f(KV[idx * 8192 + e]); B.dc[b][0] = DEC[idx * 64 + d]; }
    }
}
template <int V, int NB> __device__ __forceinline__ void m2_st(const M2Buf<V, NB>& B, float (&st)[V], bf16_t* KV, int gc0, int N, int h, int dir, int e, int s0) {
#pragma unroll
    for (int b = 0; b < NB; ++b) {
        const int n = dir ? N - 1 - (s0 + b) : (s0 + b); const size_t idx = kv_idx(gc0 + n, h, dir);
        if (V == 4) { u32x2 o; o.x = cvt_pk_bf16(st[0], st[1 % V]); o.y = cvt_pk_bf16(st[2 % V], st[3 % V]); *(u32x2*)(KV + idx * 8192 + e) = o; }
        else { KV[idx * 8192 + e] = f2bf(st[0]); }
#pragma unroll
        for (int i = 0; i < V; ++i) st[i] = B.dc[b][i] * st[i] + B.kv[b][i];
    }
}
template <int V, int NB> __device__ __forceinline__ void m2_chain(bf16_t* KV, const float* DEC, int gc0, int N, int h, int dir, int e) {
    float st[V];
#pragma unroll
    for (int i = 0; i < V; ++i) st[i] = 0.f;
    M2Buf<V, NB> A, B;
    m2_ld<V, NB>(A, KV, DEC, gc0, N, h, dir, e, 0);
    for (int s0 = 0; s0 < N; s0 += 2 * NB) {
        m2_ld<V, NB>(B, KV, DEC, gc0, N, h, dir, e, s0 + NB);
        m2_st<V, NB>(A, st, KV, gc0, N, h, dir, e, s0);
        if (s0 + 2 * NB < N) m2_ld<V, NB>(A, KV, DEC, gc0, N, h, dir, e, s0 + 2 * NB);
        m2_st<V, NB>(B, st, KV, gc0, N, h, dir, e, s0 + NB);
    }
}
__device__ void phase_m2(const Params& p) {
    int tid_l = threadIdx.x; asm volatile("" : "+v"(tid_l)); const int tid = tid_l;
    bf16_t* KV = (bf16_t*)(p.ws + OFF_R3); const float* DEC = (const float*)(p.ws + OFF_DEC);
    for (int it = blockIdx.x; it < 256; it += gridDim.x) {
        const int sc = 128 + (it >> 4), slab = it & 15;
        const int s = sc >> 3, h = (sc >> 1) & 3, dir = sc & 1;
        m2_chain<1, 16>(KV, DEC, 512 + (s - 16) * 256, 256, h, dir, slab * 512 + tid);
    }
    for (int it = blockIdx.x; it < 512; it += gridDim.x) {
        const int sc = it >> 2, slab = it & 3;
        const int s = sc >> 3, h = (sc >> 1) & 3, dir = sc & 1;
        m2_chain<4, 8>(KV, DEC, s * 32, 32, h, dir, slab * 2048 + tid * 4);
    }
}

struct M3Raw { u32x4 laf, lab, q, k, v0, v1, g0, g1, pt[4]; };
__device__ __forceinline__ void m3_load(const bf16_t* P, const bf16_t* KV, int gc, int h, int tid, M3Raw& r) {
    const bf16_t* row = P + (size_t)(gc * 64 + (tid >> 3)) * NIN + (tid & 7) * 8;
    r.laf = *(const u32x4*)(row + PC_ZF + h * 64); r.lab = *(const u32x4*)(row + PC_ZB + h * 64); r.q = *(const u32x4*)(row + PC_Q + h * 64); r.k = *(const u32x4*)(row + PC_K + h * 64);
    r.v0 = *(const u32x4*)(P + (size_t)(gc * 64 + (tid >> 4)) * NIN + PC_V + h * 128 + (tid & 15) * 8); r.v1 = *(const u32x4*)(P + (size_t)(gc * 64 + 32 + (tid >> 4)) * NIN + PC_V + h * 128 + (tid & 15) * 8);
    r.g0 = *(const u32x4*)(P + (size_t)(gc * 64 + (tid >> 4)) * NIN + PC_G + h * 128 + (tid & 15) * 8); r.g1 = *(const u32x4*)(P + (size_t)(gc * 64 + 32 + (tid >> 4)) * NIN + PC_G + h * 128 + (tid & 15) * 8);
#pragma unroll
    for (int qi = 0; qi < 4; ++qi) r.pt[qi] = *(const u32x4*)(KV + kv_idx(gc, h, qi >> 1) * 8192 + (size_t)(tid + (qi & 1) * 512) * 8);
}
__device__ void m3_gla_all(const Params& p, int l, LAS unsigned char* lds) {
    int tid_l = threadIdx.x; asm volatile("" : "+v"(tid_l)); const int tid = tid_l, wid = tid >> 6, lane = tid & 63, fr = lane & 15, fq = lane >> 4;
    const bf16_t* P = (const bf16_t*)(p.ws + OFF_R1); const bf16_t* KV = (const bf16_t*)(p.ws + OFF_R3); bf16_t* MIX = (bf16_t*)(p.ws + OFF_R2);
    constexpr int QF = 0, QB = 9216, KF = 18432, KB = 27648, VT = 36864, PTF = 55296, PTB = 73728, AT = 92160, RS = 101376, RAW = 101888;
    LAS float* RSS = (LAS float*)(lds + RS);
    const int G = gridDim.x, nit = (2048 - (int)blockIdx.x + G - 1) / G * 2;
    M3Raw R;
    if (nit > 0) m3_load(P, KV, ((int)blockIdx.x >> 2) * 2, (int)blockIdx.x & 3, tid, R);
    for (int kk = 0; kk < nit; ++kk) {
        const int item = blockIdx.x + (kk >> 1) * G, cc = kk & 1, h = item & 3, gc = (item >> 2) * 2 + cc, t0 = gc * 64;
        const float* ng = p.gla_norm_g + l * 512 + h * 128;
        { const int o = ((tid >> 3) * 72 + (tid & 7) * 8) * 2;
            *(LAS u32x4*)(lds + RAW + o) = R.laf; *(LAS u32x4*)(lds + RAW + 9216 + o) = R.lab; *(LAS u32x4*)(lds + RAW + 18432 + o) = R.q; *(LAS u32x4*)(lds + RAW + 27648 + o) = R.k;
            *(LAS u32x4*)(lds + RAW + 36864 + ((tid >> 4) * 136 + (tid & 15) * 8) * 2) = R.v0; *(LAS u32x4*)(lds + RAW + 36864 + ((32 + (tid >> 4)) * 136 + (tid & 15) * 8) * 2) = R.v1;
#pragma unroll
            for (int qi = 0; qi < 4; ++qi) { const int vv = tid + (qi & 1) * 512, v = vv >> 3, d8 = (vv & 7) * 8; *(LAS u32x4*)(lds + ((qi >> 1) ? PTB : PTF) + (v * 72 + d8) * 2) = R.pt[qi]; } }
        const u32x4 gcur0 = R.g0, gcur1 = R.g1;
        if (kk + 1 < nit) { const int itn = blockIdx.x + ((kk + 1) >> 1) * G; m3_load(P, KV, (itn >> 2) * 2 + ((kk + 1) & 1), itn & 3, tid, R); }
        __syncthreads();
        {
            const int lo = (lane * 72 + wid * 8) * 2;
            float gf[8], gb[8], q[8], k[8]; unpack8(*(const LAS u32x4*)(lds + RAW + lo), gf); unpack8(*(const LAS u32x4*)(lds + RAW + 9216 + lo), gb); unpack8(*(const LAS u32x4*)(lds + RAW + 18432 + lo), q); unpack8(*(const LAS u32x4*)(lds + RAW + 27648 + lo), k);
            const u32x4 rv0 = *(const LAS u32x4*)(lds + RAW + 36864 + (lane * 136 + wid * 8) * 2), rv1 = *(const LAS u32x4*)(lds + RAW + 36864 + (lane * 136 + 64 + wid * 8) * 2);
            wave_scan16(gf, gb, lane);
            float qf[8], qb[8], kf[8], kb[8];
#pragma unroll
            for (int e = 0; e < 8; ++e) { const float qs = q[e] * 0.125f; qf[e] = qs * __builtin_amdgcn_exp2f(gf[e]); qb[e] = qs * __builtin_amdgcn_exp2f(gb[e]); kf[e] = k[e] * __builtin_amdgcn_exp2f(-gf[e]); kb[e] = k[e] * __builtin_amdgcn_exp2f(-gb[e]); }
            const int o = (lane * 72 + wid * 8) * 2;
            u32x4 w;
            w.x = cvt_pk_bf16(qf[0], qf[1]); w.y = cvt_pk_bf16(qf[2], qf[3]); w.z = cvt_pk_bf16(qf[4], qf[5]); w.w = cvt_pk_bf16(qf[6], qf[7]); *(LAS u32x4*)(lds + QF + o) = w;
            w.x = cvt_pk_bf16(qb[0], qb[1]); w.y = cvt_pk_bf16(qb[2], qb[3]); w.z = cvt_pk_bf16(qb[4], qb[5]); w.w = cvt_pk_bf16(qb[6], qb[7]); *(LAS u32x4*)(lds + QB + o) = w;
            w.x = cvt_pk_bf16(kf[0], kf[1]); w.y = cvt_pk_bf16(kf[2], kf[3]); w.z = cvt_pk_bf16(kf[4], kf[5]); w.w = cvt_pk_bf16(kf[6], kf[7]); *(LAS u32x4*)(lds + KF + o) = w;
            w.x = cvt_pk_bf16(kb[0], kb[1]); w.y = cvt_pk_bf16(kb[2], kb[3]); w.z = cvt_pk_bf16(kb[4], kb[5]); w.w = cvt_pk_bf16(kb[6], kb[7]); *(LAS u32x4*)(lds + KB + o) = w;
            lds_put_col8(lds, VT, wid * 8, lane, rv0); lds_put_col8(lds, VT, 64 + wid * 8, lane, rv1);
        }
        const int itl = wid >> 1, vh = wid & 1;
        __syncthreads();
        *(LAS u32x4*)(lds + RAW + ((tid >> 4) * 136 + (tid & 15) * 8) * 2) = gcur0; *(LAS u32x4*)(lds + RAW + ((32 + (tid >> 4)) * 136 + (tid & 15) * 8) * 2) = gcur1;
#pragma unroll
        for (int tt = 0; tt < 2; ++tt) {
            const int tile = wid * 2 + tt, ti = tile >> 2, jt = tile & 3;
            f32x4 cf = {0.f, 0.f, 0.f, 0.f}, cb = {0.f, 0.f, 0.f, 0.f};
            const int ao = ((ti * 16 + fr) * 72 + fq * 8) * 2, bo = ((jt * 16 + fr) * 72 + fq * 8) * 2;
            if (jt <= ti) { cf = MFMA16(lds_frag(lds, QF + ao), lds_frag(lds, KF + bo), cf); cf = MFMA16(lds_frag(lds, QF + ao + 64), lds_frag(lds, KF + bo + 64), cf); }
            if (jt >= ti) { cb = MFMA16(lds_frag(lds, QB + ao), lds_frag(lds, KB + bo), cb); cb = MFMA16(lds_frag(lds, QB + ao + 64), lds_frag(lds, KB + bo + 64), cb); }
            const int j = jt * 16 + fr;
#pragma unroll
            for (int r = 0; r < 4; ++r) { const int i = ti * 16 + fq * 4 + r;
                const float v = (j <= i ? cf[r] : 0.f) + (j >= i ? cb[r] : 0.f);
                *(LAS bf16_t*)(lds + AT + (i * 72 + j) * 2) = f2bf(v); }
        }
        __syncthreads();
        {
            const int ao = ((itl * 16 + fr) * 72 + fq * 8) * 2;
            const bf16x8 aA0 = lds_frag(lds, AT + ao), aA1 = lds_frag(lds, AT + ao + 64), aF0 = lds_frag(lds, QF + ao), aF1 = lds_frag(lds, QF + ao + 64), aB0 = lds_frag(lds, QB + ao), aB1 = lds_frag(lds, QB + ao + 64);
            f32x4 o[4]; float sq = 0.f;
#pragma unroll
            for (int q = 0; q < 4; ++q) {
                const int vt = vh * 4 + q, bo = ((vt * 16 + fr) * 72 + fq * 8) * 2;
                f32x4 c = {0.f, 0.f, 0.f, 0.f};
                c = MFMA16(lds_frag(lds, VT + bo), aA0, c); c = MFMA16(lds_frag(lds, VT + bo + 64), aA1, c);
                c = MFMA16(lds_frag(lds, PTF + bo), aF0, c); c = MFMA16(lds_frag(lds, PTF + bo + 64), aF1, c);
                c = MFMA16(lds_frag(lds, PTB + bo), aB0, c); c = MFMA16(lds_frag(lds, PTB + bo + 64), aB1, c);
                o[q] = c; sq += (c[0] * c[0] + c[1] * c[1]) + (c[2] * c[2] + c[3] * c[3]);
            }
            sq += __shfl_xor(sq, 16); sq += __shfl_xor(sq, 32);
            if (fq == 0) RSS[(itl * 16 + fr) * 2 + vh] = sq;
            __syncthreads();
            const int i = itl * 16 + fr; const float rs = rsqrtf((RSS[i * 2] + RSS[i * 2 + 1]) * (1.0f / 128.0f) + EPSF);
#pragma unroll
            for (int q = 0; q < 4; ++q) {
                const int v4 = (vh * 4 + q) * 16 + fq * 4;
                const f32x4 gn = *(const f32x4*)(ng + v4);
                const u32x2 gw = *(const LAS u32x2*)(lds + RAW + (i * 136 + v4) * 2);
                const float g0 = bflo(gw.x), g1 = bfhi(gw.x), g2 = bflo(gw.y), g3 = bfhi(gw.y);
                u32x2 w; w.x = cvt_pk_bf16(o[q][0] * rs * gn[0] * siluf_(g0), o[q][1] * rs * gn[1] * siluf_(g1)); w.y = cvt_pk_bf16(o[q][2] * rs * gn[2] * siluf_(g2), o[q][3] * rs * gn[3] * siluf_(g3));
                *(LAS u32x2*)(lds + VT + (i * 136 + v4) * 2) = w;
            }
        }
        __syncthreads();
#pragma unroll
        for (int q = 0; q < 2; ++q) { const int vv = tid + q * 512, i = vv >> 4, c8 = (vv & 15) * 8;
            *(u32x4*)(MIX + (size_t)(t0 + i) * DM + h * 128 + c8) = *(const LAS u32x4*)(lds + VT + (i * 136 + c8) * 2); }
    }
}

__device__ void m3_sgu(const Params& p, int l, int tb, LAS unsigned char* lds) {
    int tid_l = threadIdx.x; asm volatile("" : "+v"(tid_l)); const int tid = tid_l, wid = tid >> 6, lane = tid & 63, fr = lane & 15, fq = lane >> 4;
    const bf16_t* P = (const bf16_t*)(p.ws + OFF_R1); bf16_t* MIX = (bf16_t*)(p.ws + OFF_R2);
    constexpr int VT = 0, WS = 256 * 136 * 2, PART = WS + 128 * 136 * 2, RAWS = PART + 4096;
    const int tbase = tb * 128;
    f32x4 wreg[8];
    { const float* wsrc = p.sgu_w + ((size_t)(l * 4) * 128) * 128;
#pragma unroll
        for (int q = 0; q < 8; ++q) wreg[q] = *(const f32x4*)(wsrc + (size_t)(tid + q * 512) * 4); }
    u32x4 xin[2][4];
#pragma unroll
    for (int hf = 0; hf < 2; ++hf)
#pragma unroll
        for (int q = 0; q < 4; ++q) { const int vv = tid + q * 512; xin[hf][q] = *(const u32x4*)(P + (size_t)(tbase + hf * 64 + (vv >> 5)) * NIN + PC_VS + (vv & 31) * 8); }
#pragma unroll
    for (int hf = 0; hf < 2; ++hf) {
#pragma unroll
        for (int q = 0; q < 4; ++q) { const int vv = tid + q * 512; *(LAS u32x4*)(lds + RAWS + ((vv >> 5) * 264 + (vv & 31) * 8) * 2) = xin[hf][q]; }
        __syncthreads();
        const int s = tid & 63, cg = tid >> 6;
        u32x4 xr[4];
#pragma unroll
        for (int q = 0; q < 4; ++q) xr[q] = *(const LAS u32x4*)(lds + RAWS + (s * 264 + cg * 32 + q * 8) * 2);
        float sm = 0.f, sq = 0.f;
#pragma unroll
        for (int q = 0; q < 4; ++q) { float x[8]; unpack8(xr[q], x);
#pragma unroll
            for (int e = 0; e < 8; ++e) { sm += x[e]; sq += x[e] * x[e]; } }
        *(LAS f32x2v*)(lds + PART + (cg * 64 + s) * 8) = (f32x2v){sm, sq};
        __syncthreads();
        float tsm = 0.f, tsq = 0.f;
#pragma unroll
        for (int g = 0; g < 8; ++g) { const f32x2v t = *(const LAS f32x2v*)(lds + PART + (g * 64 + s) * 8); tsm += t.x; tsq += t.y; }
        const float mu = tsm * (1.0f / 256.0f), rstd = rsqrtf(fmaxf(tsq * (1.0f / 256.0f) - mu * mu, 0.f) + EPSF);
        const float* lg = p.sgu_ln_g + l * 256 + cg * 32; const float* lb = p.sgu_ln_b + l * 256 + cg * 32;
#pragma unroll
        for (int q = 0; q < 4; ++q) { float x[8]; unpack8(xr[q], x);
            const f32x4 g0 = *(const f32x4*)(lg + q * 8), g1 = *(const f32x4*)(lg + q * 8 + 4), b0 = *(const f32x4*)(lb + q * 8), b1 = *(const f32x4*)(lb + q * 8 + 4);
            LAS unsigned char* wp = lds + VT + ((cg * 32 + q * 8) * 136 + hf * 64 + s) * 2;
#pragma unroll
            for (int e = 0; e < 8; ++e) { const float y = (x[e] - mu) * rstd * (e < 4 ? g0[e & 3] : g1[e & 3]) + (e < 4 ? b0[e & 3] : b1[e & 3]);
                *(LAS bf16_t*)(wp + e * 272) = f2bf(y); } }
    }
    for (int h = 0; h < 4; ++h) {
#pragma unroll
        for (int q = 0; q < 8; ++q) { const int vv = tid + q * 512, t = vv >> 5, s4 = (vv & 31) * 4;
            u32x2 w; w.x = cvt_pk_bf16(wreg[q][0], wreg[q][1]); w.y = cvt_pk_bf16(wreg[q][2], wreg[q][3]);
            *(LAS u32x2*)(lds + WS + (t * 136 + s4) * 2) = w; }
        const int t = tbase + wid * 16 + fr;
        u32x2 uw[4];
#pragma unroll
        for (int ct = 0; ct < 4; ++ct) uw[ct] = *(const u32x2*)(P + (size_t)t * NIN + PC_U + h * 64 + ct * 16 + fq * 4);
        const float bs = p.sgu_b[(l * 4 + h) * 128 + wid * 16 + fr];
        if (h < 3) { const float* wsrc = p.sgu_w + ((size_t)(l * 4 + h + 1) * 128) * 128;
#pragma unroll
            for (int q = 0; q < 8; ++q) wreg[q] = *(const f32x4*)(wsrc + (size_t)(tid + q * 512) * 4); }
        __syncthreads();
        {
            const int ao = WS + ((wid * 16 + fr) * 136 + fq * 8) * 2;
            bf16x8 a[4];
#pragma unroll
            for (int ks = 0; ks < 4; ++ks) a[ks] = lds_frag(lds, ao + ks * 64);
#pragma unroll
            for (int ct = 0; ct < 4; ++ct) {
                const int bo = VT + ((h * 64 + ct * 16 + fr) * 136 + fq * 8) * 2;
                f32x4 c = {0.f, 0.f, 0.f, 0.f};
#pragma unroll
                for (int ks = 0; ks < 4; ++ks) c = MFMA16(lds_frag(lds, bo + ks * 64), a[ks], c);
                const int c4 = h * 64 + ct * 16 + fq * 4;
                u32x2 w; w.x = cvt_pk_bf16((c[0] + bs) * bflo(uw[ct].x), (c[1] + bs) * bfhi(uw[ct].x)); w.y = cvt_pk_bf16((c[2] + bs) * bflo(uw[ct].y), (c[3] + bs) * bfhi(uw[ct].y));
                *(u32x2*)(MIX + (size_t)t * DM + 512 + c4) = w;
            }
        }
        __syncthreads();
    }
}

__device__ void m3_pool(const Params& p, int l, int tb, LAS unsigned char* lds) {
    int tid_l = threadIdx.x; asm volatile("" : "+v"(tid_l)); const int tid = tid_l, wid = tid >> 6, lane = tid & 63, fr = lane & 15, fq = lane >> 4;
    const bf16_t* P = (const bf16_t*)(p.ws + OFF_R1); bf16_t* MIX = (bf16_t*)(p.ws + OFF_R2);
    constexpr int XO = 0, DD = 144 * 256 * 2, PW = 0;
    const int tbase = tb * 128; int s0, S; seq_of(tbase, s0, S); const int s1 = s0 + S;
    f32x4 pw[8];
#pragma unroll
    for (int q = 0; q < 8; ++q) pw[q] = *(const f32x4*)(p.pool_w + (size_t)l * 16384 + (size_t)(tid + q * 512) * 4);
#pragma unroll 3
    for (int q = 0; q < 9; ++q) { const int vv = tid + q * 512, rl = vv >> 5, c8 = (vv & 31) * 8; const int t = tbase - 8 + rl;
        u32x4 w = {0u, 0u, 0u, 0u};
        if (t >= s0 && t < s1) w = *(const u32x4*)(P + (size_t)t * NIN + PC_XP + c8);
        *(LAS u32x4*)(lds + XO + (rl * 256 + c8) * 2) = w; }
    __syncthreads();
    {
        const int c = tid & 63, gi = (tid >> 6) & 3, half = tid >> 8, hh = 1 << gi, col = gi * 64 + c;
        const int tA = tbase + half * 64;
        LAS unsigned char* xc = lds + XO + col * 2 - (tbase - 8) * 512;
        int lo = tA - hh; if (lo < s0) lo = s0; int hi = tA + hh; if (hi > s1) hi = s1;
        float sum = 0.f;
        for (int r = lo; r < hi; ++r) sum += bf2f(*(LAS bf16_t*)(xc + r * 512));
#pragma unroll 4
        for (int t = tA; t < tA + 64; ++t) {
            const float x = bf2f(*(LAS bf16_t*)(xc + t * 512));
            const float dv = sum * __builtin_amdgcn_rcpf((float)(hi - lo)) - x;
            *(LAS bf16_t*)(lds + DD + ((t - tbase) * 264 + col) * 2) = f2bf(dv);
            int nlo = t + 1 - hh; if (nlo < s0) nlo = s0; int nhi = t + 1 + hh; if (nhi > s1) nhi = s1;
            if (nhi > hi) sum += bf2f(*(LAS bf16_t*)(xc + hi * 512));
            if (nlo > lo) sum -= bf2f(*(LAS bf16_t*)(xc + lo * 512));
            lo = nlo; hi = nhi;
        }
    }
    __syncthreads();
#pragma unroll
    for (int q = 0; q < 8; ++q) { const int el = (tid + q * 512) * 4, g = el >> 12, c = (el >> 6) & 63, dd4 = el & 63;
#pragma unroll
        for (int i = 0; i < 4; ++i) *(LAS bf16_t*)(lds + PW + g * 9216 + ((dd4 + i) * 72 + c) * 2) = f2bf(pw[q][i]); }
    __syncthreads();
    {
        const int t = tbase + wid * 16 + fr;
#pragma unroll
        for (int gi = 0; gi < 4; ++gi) {
            const int ao = DD + ((wid * 16 + fr) * 264 + gi * 64 + fq * 8) * 2;
            const bf16x8 a0 = lds_frag(lds, ao), a1 = lds_frag(lds, ao + 64);
#pragma unroll
            for (int dt = 0; dt < 4; ++dt) {
                const int bo = PW + gi * 9216 + ((dt * 16 + fr) * 72 + fq * 8) * 2;
                f32x4 c = {0.f, 0.f, 0.f, 0.f};
                c = MFMA16(lds_frag(lds, bo), a0, c); c = MFMA16(lds_frag(lds, bo + 64), a1, c);
                const int d4 = gi * 64 + dt * 16 + fq * 4;
                const f32x4 sc = *(const f32x4*)(p.pool_scale + l * 256 + d4);
                u32x2 w; w.x = cvt_pk_bf16(c[0] * sc[0], c[1] * sc[1]); w.y = cvt_pk_bf16(c[2] * sc[2], c[3] * sc[3]);
                *(u32x2*)(MIX + (size_t)t * DM + 768 + d4) = w;
            }
        }
    }
    __syncthreads();
}

__device__ void phase_m3(const Params& p, int l, LAS unsigned char* lds) {
    m3_gla_all(p, l, lds);
#pragma nounroll
    for (int item = blockIdx.x; item < 512; item += gridDim.x) { m3_sgu(p, l, item, lds); }
#pragma nounroll
    for (int item = blockIdx.x; item < 512; item += gridDim.x) { m3_pool(p, l, item, lds); }
}

template <class Sched> __device__ __forceinline__ void fix_panels(const Params& p, int l, const Sched& S) {
    bf16_t* ACT = (bf16_t*)(p.ws + OFF_R1); const float* side = (const float*)(p.ws + OFF_R2);
    const float* cw = p.conv_w + (size_t)l * 3 * DFF;
    int tid_l = threadIdx.x; asm volatile("" : "+v"(tid_l)); const int tid = tid_l;
    Unit u;
    for (int ui = 0; S.next(ui, u); ++ui) {
#pragma unroll 4
        for (int i = tid; i < 8 * (DFF / 4); i += 512) {
            const int c4 = (i % (DFF / 4)) * 4, rb = i / (DFF / 4), blk = u.pm * 4 + (rb >> 1), last = rb & 1;
            const int row = blk * 64 + (last ? 63 : 0);
            int s0, Sq; seq_of(row, s0, Sq);
            const float* sb = side + (size_t)blk * 6 * DFF + (last ? 3 * DFF : 0) + c4;
            f32x4 z = *(const f32x4*)sb; const f32x4 up = *(const f32x4*)(sb + DFF);
            if (!last && row != s0) { const f32x4 an = *(const f32x4*)(side + (size_t)(blk - 1) * 6 * DFF + 5 * DFF + c4), w = *(const f32x4*)(cw + c4); z += w * an; }
            if (last && row != s0 + Sq - 1) { const f32x4 an = *(const f32x4*)(side + (size_t)(blk + 1) * 6 * DFF + 2 * DFF + c4), w = *(const f32x4*)(cw + 2 * DFF + c4); z += w * an; }
            u32x2 o; o.x = cvt_pk_bf16(siluf_(z[0]) * up[0], siluf_(z[1]) * up[1]); o.y = cvt_pk_bf16(siluf_(z[2]) * up[2], siluf_(z[3]) * up[3]);
            *(u32x2*)(ACT + (size_t)row * DFF + c4) = o;
        }
    }
    asm volatile("s_waitcnt vmcnt(0)" ::: "memory");
    __syncthreads();
}

__device__ void phase_final(const Params& p) {
    const float* SS1 = (const float*)(p.ws + OFF_SS1); const bf16_t* X = (const bf16_t*)(p.ws + OFF_R2);
    int tid_l = threadIdx.x; asm volatile("" : "+v"(tid_l)); const int tid = tid_l, wid = tid >> 6, lane = tid & 63;
    f32x4 g[4];
#pragma unroll
    for (int h = 0; h < 2; ++h) { g[2 * h] = *(const f32x4*)(p.norm_f + h * 512 + lane * 8); g[2 * h + 1] = *(const f32x4*)(p.norm_f + h * 512 + lane * 8 + 4); }
    for (int row0 = (blockIdx.x * 8 + wid) * 4; row0 < T_TOK; row0 += gridDim.x * 32) {
        u32x4 w[4][2]; float rs[4];
#pragma unroll
        for (int r = 0; r < 4; ++r) { rs[r] = sum16(SS1 + (size_t)(row0 + r) * 16); w[r][0] = *(const u32x4*)(X + (size_t)(row0 + r) * DM + lane * 8); w[r][1] = *(const u32x4*)(X + (size_t)(row0 + r) * DM + 512 + lane * 8); }
#pragma unroll
        for (int r = 0; r < 4; ++r) {
            const float sc = rsqrtf(rs[r] * (1.0f / 1024.0f) + EPSF);
            float* xr = p.out + (size_t)(row0 + r) * DM;
#pragma unroll
            for (int h = 0; h < 2; ++h) { float x[8]; unpack8(w[r][h], x);
                *(f32x4*)(xr + h * 512 + lane * 8) = (f32x4){x[0], x[1], x[2], x[3]} * sc * g[2 * h]; *(f32x4*)(xr + h * 512 + lane * 8 + 4) = (f32x4){x[4], x[5], x[6], x[7]} * sc * g[2 * h + 1]; }
        }
    }
}

#define XB_TMO      128
#define XB_XCNT(j)  (256  + 64 * (j))
#define XB_XSUB(j)  (1280 + 64 * (j))
#define XB_XGEN(j)  (2304 + 64 * (j))
#define XB_TOP      3328
#define XB_TOPGEN   3392
#define XCD_BAR_WORDS 3456
#define XB_SPIN_CAP (1u << 18)
__device__ __forceinline__ unsigned xb_ld(unsigned* p)              { return __hip_atomic_load(p, __ATOMIC_RELAXED, __HIP_MEMORY_SCOPE_AGENT); }
__device__ __forceinline__ unsigned xb_add(unsigned* p, unsigned v) { return __hip_atomic_fetch_add(p, v, __ATOMIC_RELAXED, __HIP_MEMORY_SCOPE_AGENT); }
__device__ __forceinline__ unsigned xb_xcc_id() { return (unsigned)__builtin_amdgcn_s_getreg((3 << 11) | 20) & 0xFu; }
#define XB_SPIN(cond, bar) do { unsigned _sp = 0; while (cond) { __builtin_amdgcn_s_sleep(1); \
    if ((++_sp & 255u) == 0u) { if (xb_ld(&(bar)[XB_TMO])) break; if (_sp > XB_SPIN_CAP) { atomicAdd(&(bar)[XB_TMO], 1u); break; } } } } while (0)

struct XcdBarrier {
    unsigned* bar; unsigned x;
    volatile LAS unsigned* st;
};

__device__ __forceinline__ XcdBarrier xcd_barrier_post(unsigned* bar, volatile LAS unsigned* st) {
    XcdBarrier b; b.bar = bar; b.x = xb_xcc_id(); b.st = st;
    if (threadIdx.x == 0) (void)xb_add(&bar[XB_XCNT(b.x)], 1u);
    return b;
}
__device__ __forceinline__ void xcd_barrier_complete(unsigned* bar, unsigned x, unsigned& nloc, unsigned& nx) {
    const unsigned G = gridDim.x * gridDim.y * gridDim.z;
    unsigned sum, cnt, mine, sp = 0u;
    for (;;) {
        sum = 0u; cnt = 0u; mine = 0u;
#pragma unroll
        for (unsigned j = 0; j < 16; ++j) { const unsigned c = xb_ld(&bar[XB_XCNT(j)]); sum += c; cnt += (c > 0u) ? 1u : 0u; mine = (j == x) ? c : mine; }
        if (sum == G) break;
        __builtin_amdgcn_s_sleep(1);
        if ((++sp & 255u) == 0u) { if (xb_ld(&bar[XB_TMO])) break; if (sp > XB_SPIN_CAP) { atomicAdd(&bar[XB_TMO], 1u); break; } }
    }
    nloc = mine > 0u ? mine : 1u; nx = cnt > 0u ? cnt : 1u;
}

__device__ __forceinline__ void xcd_barrier(const XcdBarrier& b) {
    asm volatile("s_waitcnt vmcnt(0)" ::: "memory");
    __syncthreads();
    if (threadIdx.x == 0) {
        unsigned* bar = b.bar;
        __builtin_amdgcn_s_waitcnt(0);
        unsigned nloc = b.st[0], nx = b.st[1];
        if (nloc == 0u) { xcd_barrier_complete(bar, b.x, nloc, nx); b.st[0] = nloc; b.st[1] = nx; }
        const unsigned old = xb_add(&bar[XB_XSUB(b.x)], 1u);
        const unsigned gen = old / nloc;
        if (old + 1u == (gen + 1u) * nloc) {
            __builtin_amdgcn_fence(__ATOMIC_RELEASE, "agent");
            asm volatile("s_waitcnt vmcnt(0)" ::: "memory");
            const unsigned og = xb_add(&bar[XB_TOP], 1u);
            const unsigned tg = og / nx;
            if (og + 1u == (tg + 1u) * nx) xb_add(&bar[XB_TOPGEN], 1u);
            else XB_SPIN(xb_ld(&bar[XB_TOPGEN]) == tg, bar);
            __builtin_amdgcn_fence(__ATOMIC_ACQUIRE, "agent");
            xb_add(&bar[XB_XGEN(b.x)], 1u);
            asm volatile("s_waitcnt vmcnt(0)" ::: "memory");
        } else {
            XB_SPIN(xb_ld(&bar[XB_XGEN(b.x)]) == gen, bar);
            __builtin_amdgcn_fence(__ATOMIC_ACQUIRE, "agent");
            asm volatile("s_waitcnt vmcnt(0)" ::: "memory");
        }
    }
    __syncthreads();
}

#ifndef MK_SYNC
#define MK_SYNC() xcd_barrier(xb)
#define MK_SYNC_CG() do { asm volatile("s_waitcnt vmcnt(0)" ::: "memory"); grid.sync(); } while (0)
#endif
__global__ void __launch_bounds__(512, 2) fwd_megakernel(Params p) {
    extern __shared__ __attribute__((aligned(16))) unsigned char shm[];
    LAS unsigned char* lds = (LAS unsigned char*)shm;
    cg::grid_group grid = cg::this_grid();
    bf16_t* WB = (bf16_t*)(p.ws + OFF_WB);
    bf16_t* R1 = (bf16_t*)(p.ws + OFF_R1); bf16_t* R2 = (bf16_t*)(p.ws + OFF_R2); bf16_t* R3 = (bf16_t*)(p.ws + OFF_R3);
    float* SS1 = (float*)(p.ws + OFF_SS1); float* SS2 = (float*)(p.ws + OFF_SS2); bf16_t* XBUF = (bf16_t*)p.out;
    StaticOrder S;
    volatile LAS unsigned* xst = (volatile LAS unsigned*)(lds + 163840 - 16);
    if (threadIdx.x < 2) xst[threadIdx.x] = 0u;
    __syncthreads();
    const XcdBarrier xb = xcd_barrier_post((unsigned*)(p.ws + OFF_BAR), xst);
    phase_prep(p, lds);
    MK_SYNC();
    if (p.ws == nullptr) MK_SYNC_CG();
    for (int l = 0; l < NLAYER; ++l) {
        const bf16_t* wl = WB + (size_t)l * WB_LAYER;
        { StaticOrder S1, S2; S.init(T_TOK, 1792, (int)gridDim.x, (int)blockIdx.x); S1.init(T_TOK, 512, (int)gridDim.x, (int)blockIdx.x); S2 = S1;
            precompute_rs(lds, S, SS1, 0, false); precompute_rs(lds, S1, SS1, 7, true);
            { Gemm g{XBUF, wl + WB_IN, T_TOK, 1792, DM};
                EpiIn<0> E{R1, nullptr, 0, 0};
                gemm_phase<EpiIn<0>, StaticOrder, false>(lds, g, S, E, nullptr); }
            { Gemm g{XBUF, wl + WB_IN + (size_t)1792 * DM, T_TOK, 512, DM};
                EpiIn<1> E{R1, nullptr, 1792, 7};
                gemm_phase<EpiIn<1>, StaticOrder, false>(lds, g, S1, E, nullptr); }
            { Gemm g{XBUF, wl + WB_IN + (size_t)2304 * DM, T_TOK, 512, DM};
                EpiIn<2> E{R1, p.gate_b + l * 512, 2304, 7};
                gemm_phase<EpiIn<2>, StaticOrder, false>(lds, g, S2, E, nullptr); } }
        MK_SYNC();
        phase_m1(p, lds);
        MK_SYNC();
        phase_m2(p);
        MK_SYNC();
        phase_m3(p, l, lds);
        MK_SYNC();
        { Gemm g{R2, wl + WB_O, T_TOK, DM, DM}; S.init(g.M, g.N, (int)gridDim.x, (int)blockIdx.x);
            EpiRes E{XBUF, R3, SS2};
            gemm_phase<EpiRes, StaticOrder, false>(lds, g, S, E, nullptr); }
        MK_SYNC();
        { Gemm g{R3, wl + WB_1, T_TOK, 2 * DFF, DM}; S.init(g.M, g.N, (int)gridDim.x, (int)blockIdx.x);
            EpiFfn E{R1, SS2, p.conv_w + (size_t)l * 3 * DFF, p.conv_b + (size_t)l * DFF, (float*)R2};
            precompute_rs(lds, S, SS2);
            gemm_phase<EpiFfn, StaticOrder, false>(lds, g, S, E, nullptr); }
        MK_SYNC();
        { Gemm g{R1, wl + WB_2, T_TOK, DM, DFF}; S.init(g.M, g.N, (int)gridDim.x, (int)blockIdx.x);
            fix_panels(p, l, S);
            EpiRes E{R3, l == NLAYER - 1 ? R2 : XBUF, SS1};
            gemm_phase<EpiRes, StaticOrder, false>(lds, g, S, E, nullptr); }
        MK_SYNC();
    }
    phase_final(p);
}

extern "C" void kernel_launch(void* const* d_in, const int* in_sizes, int n_in, void* d_out, int out_size, void* d_ws, size_t ws_size, hipStream_t stream) {
    constexpr size_t kDynLds = 160 * 1024;
    static int grid_blocks = 0;
    if (!grid_blocks) {
        (void)hipFuncSetAttribute((const void*)fwd_megakernel, hipFuncAttributeMaxDynamicSharedMemorySize, (int)kDynLds);
        int dev = 0, cus = 0, per_cu = 0;
        (void)hipGetDevice(&dev);
        (void)hipDeviceGetAttribute(&cus, hipDeviceAttributeMultiprocessorCount, dev);
        (void)hipOccupancyMaxActiveBlocksPerMultiprocessor(&per_cu, fwd_megakernel, 512, kDynLds);
        grid_blocks = cus * per_cu;
        if (grid_blocks > 256) grid_blocks = 256;
    }
    if (ws_size < OFF_END) { fprintf(stderr, "workspace too small\n"); return; }
    Params p{};
    p.x_prompt = (const float*)d_in[0]; p.x_sample = (const float*)d_in[1]; p.norm1_g = (const float*)d_in[2]; p.w_in = (const float*)d_in[3]; p.gate_w2 = (const float*)d_in[4];
    p.gate_b = (const float*)d_in[5]; p.gla_norm_g = (const float*)d_in[6]; p.sgu_ln_g = (const float*)d_in[7]; p.sgu_ln_b = (const float*)d_in[8]; p.sgu_w = (const float*)d_in[9];
    p.sgu_b = (const float*)d_in[10]; p.pool_w = (const float*)d_in[11]; p.pool_scale = (const float*)d_in[12]; p.w_o = (const float*)d_in[13]; p.norm2_g = (const float*)d_in[14];
    p.w_ffn_in = (const float*)d_in[15]; p.conv_w = (const float*)d_in[16]; p.conv_b = (const float*)d_in[17]; p.w_ffn_out = (const float*)d_in[18]; p.norm_f = (const float*)d_in[19];
    p.out = (float*)d_out; p.ws = (unsigned char*)d_ws;
    (void)hipMemsetAsync((char*)d_ws + OFF_BAR, 0, 16384, stream);
    void* args[] = {&p};
    hipError_t e = hipLaunchCooperativeKernel((void*)fwd_megakernel, dim3(grid_blocks), dim3(512), args, kDynLds, stream);
    if (e != hipSuccess) fprintf(stderr, "cooperative launch failed: %s (grid %d)\n", hipGetErrorString(e), grid_blocks);
}
```
